# Optimizing an MI355X kernel written in HIP

```python
import math
import jax, jax.numpy as jnp
from jax import lax
import numpy as np

D_MODEL = 2048
BATCH = 2
SEQ = 4096
DEPTH = 1

GRID_W = 64
CTX_LEN = 256
RET_HEADS = 4
RET_DK = 256
RET_DV = 256
GLA_HEADS = 4
GLA_DK = 128
GLA_DV = 256
GLA_LOW_RANK = 16
GLA_GATE_NORM = 16.0
CHUNK = 64
D_FF = ((8 * D_MODEL // 3 + 255) // 256) * 256
ROPE_BASE = 10000.0
EPS = 1e-6

RET_QK = RET_HEADS * RET_DK
RET_VW = RET_HEADS * RET_DV
GLA_KW = GLA_HEADS * GLA_DK
GLA_VW = GLA_HEADS * GLA_DV
SPLIT_SIZES = (RET_QK, RET_VW, GLA_KW, GLA_VW, 2 * GLA_LOW_RANK,
               RET_QK, RET_VW, GLA_KW, GLA_VW, D_MODEL, D_MODEL)
N_CTX_COLS = RET_QK + RET_VW + GLA_KW + GLA_VW + 2 * GLA_LOW_RANK
D_IN = sum(SPLIT_SIZES)

kernel_name = 'hybrid_retention_gla_block'


def rms_norm(t, w):
    tf = t.astype(jnp.float32)
    return tf * lax.rsqrt(jnp.mean(tf * tf, axis=-1, keepdims=True) + EPS) * w


def split_cols(p, sizes):
    offsets = []
    acc = 0
    for s in sizes[:-1]:
        acc += s
        offsets.append(acc)
    return jnp.split(p, offsets, axis=-1)


def to_heads(t, n_heads):
    b, l, _ = t.shape
    return t.reshape(b, l, n_heads, -1).transpose(0, 2, 1, 3).astype(jnp.float32)


def merge_heads(t):
    b, h, l, d = t.shape
    return t.transpose(0, 2, 1, 3).reshape(b, l, h * d)


def axial_rope_tables(pos_r, pos_c, dk):
    n_f = dk // 4
    inv = ROPE_BASE ** (-jnp.arange(n_f, dtype=jnp.float32) / n_f)
    ang = jnp.concatenate([pos_r[:, None] * inv, pos_c[:, None] * inv], axis=-1)
    return jnp.cos(ang), jnp.sin(ang)


def apply_rope(t, cos, sin):
    half = t.shape[-1] // 2
    t1, t2 = t[..., :half], t[..., half:]
    return jnp.concatenate([t1 * cos - t2 * sin, t1 * sin + t2 * cos], axis=-1)


def head_layer_norm(o):
    mu = jnp.mean(o, axis=-1, keepdims=True)
    var = jnp.mean(jnp.square(o - mu), axis=-1, keepdims=True)
    return (o - mu) * lax.rsqrt(var + EPS)


def head_rms_norm(o):
    return o * lax.rsqrt(jnp.mean(o * o, axis=-1, keepdims=True) + EPS)


def ctx_final_state(k, v, log_a):
    b = jnp.cumsum(log_a, axis=2)
    w = jnp.exp(b[:, :, -1:, :] - b)
    return jnp.einsum('bhjd,bhjv->bhdv', k * w, v)


def chunk_recurrence(q, k, v, log_a, s0, exclusive):
    bsz, nh, length, _ = q.shape
    dv = v.shape[-1]
    n_chunks = length // CHUNK
    scalar = log_a.shape[-1] == 1
    mask = jnp.tril(jnp.ones((CHUNK, CHUNK), dtype=bool), k=-1 if exclusive else 0)

    def chunks(t):
        return jnp.moveaxis(t.reshape(bsz, nh, n_chunks, CHUNK, t.shape[-1]), 2, 0)

    def step(s, inp):
        qc, kc, vc, ac = inp
        b = jnp.cumsum(ac, axis=2)
        b_last = b[:, :, -1:, :]
        diff = b[:, :, :, None, :] - b[:, :, None, :, :]
        decay = jnp.exp(jnp.where(mask[:, :, None], diff, -jnp.inf))
        if scalar:
            scores = jnp.einsum('bhid,bhjd->bhij', qc, kc) * decay[..., 0]
        else:
            scores = jnp.einsum('bhid,bhjd,bhijd->bhij', qc, kc, decay)
        o = (jnp.einsum('bhij,bhjv->bhiv', scores, vc)
             + jnp.einsum('bhid,bhdv->bhiv', qc * jnp.exp(b), s))
        s_new = (jnp.exp(b_last[:, :, 0, :, None]) * s
                 + jnp.einsum('bhjd,bhjv->bhdv', kc * jnp.exp(b_last - b), vc))
        return s_new, o

    _, o = lax.scan(step, s0, (chunks(q), chunks(k), chunks(v), chunks(log_a)))
    return jnp.moveaxis(o, 0, 2).reshape(bsz, nh, length, dv)


def bidirectional_recurrence(q, k, v, la_f, la_b, kc, vc, lac_f, lac_b):
    flip = lambda t: jnp.flip(t, axis=2)
    s_f = ctx_final_state(kc, vc, lac_f)
    s_b = ctx_final_state(flip(kc), flip(vc), flip(lac_b))
    o_f = chunk_recurrence(q, k, v, la_f, s_f, False)
    o_b = flip(chunk_recurrence(flip(q), flip(k), flip(v), flip(la_b), s_b, True))
    return o_f + o_b


def hybrid_mixer(h, hc, w_in, ret_decay, gla_a_up, gla_a_bias, ret_gn, gla_gn,
                 w_up_ret, w_up_gla, w_out, cos, sin):
    f32 = jnp.float32
    bsz, length, _ = h.shape
    lc = hc.shape[1]
    p = h @ w_in
    pc = hc @ w_in[:, :N_CTX_COLS]
    rk, rv, gk, gv, ga, rq, rg, gq, gg, gate_a, gate_b = split_cols(p, SPLIT_SIZES)
    rkc, rvc, gkc, gvc, gac = split_cols(pc, SPLIT_SIZES[:5])

    log_gamma = -jnp.exp(ret_decay.astype(f32))

    def ret_la(n, d):
        return jnp.broadcast_to(log_gamma[d][None, :, None, None], (bsz, RET_HEADS, n, 1))

    q_r = apply_rope(to_heads(rq, RET_HEADS), cos, sin) * (RET_DK ** -0.5)
    k_r = apply_rope(to_heads(rk, RET_HEADS), cos, sin)
    o_r = bidirectional_recurrence(q_r, k_r, to_heads(rv, RET_HEADS), ret_la(length, 0), ret_la(length, 1),
                                   to_heads(rkc, RET_HEADS), to_heads(rvc, RET_HEADS),
                                   ret_la(lc, 0), ret_la(lc, 1))
    o_r = merge_heads(head_layer_norm(o_r)) * ret_gn * jax.nn.silu(rg.astype(f32))
    y_ret = o_r @ w_up_ret

    def gla_la(a_low, d):
        z = a_low[..., d * GLA_LOW_RANK:(d + 1) * GLA_LOW_RANK] @ gla_a_up[d] + gla_a_bias[d]
        return to_heads(jax.nn.log_sigmoid(z.astype(f32)) / GLA_GATE_NORM, GLA_HEADS)

    q_g = to_heads(gq, GLA_HEADS) * (GLA_DK ** -0.5)
    o_g = bidirectional_recurrence(q_g, to_heads(gk, GLA_HEADS), to_heads(gv, GLA_HEADS),
                                   gla_la(ga, 0), gla_la(ga, 1),
                                   to_heads(gkc, GLA_HEADS), to_heads(gvc, GLA_HEADS),
                                   gla_la(gac, 0), gla_la(gac, 1))
    o_g = merge_heads(head_rms_norm(o_g)) * gla_gn * jax.nn.silu(gg.astype(f32))
    y_gla = o_g @ w_up_gla

    merged = jax.nn.sigmoid(gate_a.astype(f32)) * y_ret + jax.nn.sigmoid(gate_b.astype(f32)) * y_gla
    return merged @ w_out


def setup_inputs(seed: int = 0) -> dict:
    key = jax.random.key(seed)
    ks = jax.random.split(key, 24)
    f32 = jnp.float32

    def nrm(k, shape, scale):
        return jax.random.normal(k, shape, f32) * scale

    ret_init = np.log(-np.log(1.0 - np.exp(np.linspace(np.log(1.0 / 32), np.log(1.0 / 512), RET_HEADS))))
    ret_decay = jnp.asarray(ret_init, f32)[None, None, :] + nrm(ks[10], (DEPTH, 2, RET_HEADS), 0.05)
    return {
        'x': nrm(ks[0], (BATCH, SEQ, D_MODEL), 1.0),
        'c': nrm(ks[1], (BATCH, D_MODEL), 1.0),
        'ctx': nrm(ks[2], (BATCH, CTX_LEN, D_MODEL), 1.0),
        'c_ctx': nrm(ks[3], (D_MODEL,), 1.0),
        'w_mod': nrm(ks[4], (DEPTH, D_MODEL, 6 * D_MODEL), 0.5 * D_MODEL ** -0.5),
        'b_mod': nrm(ks[5], (DEPTH, 6 * D_MODEL), 0.01),
        'norm_mix_pre': 1.0 + nrm(ks[6], (DEPTH, D_MODEL), 0.05),
        'norm_mix_post': 1.0 + nrm(ks[7], (DEPTH, D_MODEL), 0.05),
        'norm_ffn_pre': 1.0 + nrm(ks[8], (DEPTH, D_MODEL), 0.05),
        'norm_ffn_post': 1.0 + nrm(ks[9], (DEPTH, D_MODEL), 0.05),
        'w_in': nrm(ks[11], (DEPTH, D_MODEL, D_IN), D_MODEL ** -0.5),
        'ret_decay': ret_decay,
        'gla_a_up': nrm(ks[12], (DEPTH, 2, GLA_LOW_RANK, GLA_KW), GLA_LOW_RANK ** -0.5),
        'gla_a_bias': nrm(ks[13], (DEPTH, 2, GLA_KW), 0.01),
        'ret_gn': 1.0 + nrm(ks[14], (DEPTH, RET_VW), 0.05),
        'gla_gn': 1.0 + nrm(ks[15], (DEPTH, GLA_VW), 0.05),
        'w_up_ret': nrm(ks[16], (DEPTH, RET_VW, D_MODEL), RET_VW ** -0.5),
        'w_up_gla': nrm(ks[17], (DEPTH, GLA_VW, D_MODEL), GLA_VW ** -0.5),
        'w_out': nrm(ks[18], (DEPTH, D_MODEL, D_MODEL), D_MODEL ** -0.5),
        'ffn_w_gate': nrm(ks[19], (DEPTH, D_MODEL, D_FF), D_MODEL ** -0.5),
        'ffn_w_up': nrm(ks[20], (DEPTH, D_MODEL, D_FF), D_MODEL ** -0.5),
        'ffn_w_down': nrm(ks[21], (DEPTH, D_FF, D_MODEL), D_FF ** -0.5),
    }


def reference(x, c, ctx, c_ctx, w_mod, b_mod, norm_mix_pre, norm_mix_post, norm_ffn_pre, norm_ffn_post,
              w_in, ret_decay, gla_a_up, gla_a_bias, ret_gn, gla_gn, w_up_ret, w_up_gla, w_out,
              ffn_w_gate, ffn_w_up, ffn_w_down):
    f32 = jnp.float32
    out_dtype = x.dtype
    length = x.shape[1]
    rows = length // GRID_W
    pos_r = jnp.repeat(jnp.arange(rows, dtype=f32), GRID_W)
    pos_c = jnp.tile(jnp.arange(GRID_W, dtype=f32), rows)
    cos, sin = axial_rope_tables(pos_r, pos_c, RET_DK)

    h_state = x.astype(f32)
    for i in range(DEPTH):
        mod = jax.nn.silu(c.astype(f32)) @ w_mod[i] + b_mod[i]
        sh1, sc1, g1, sh2, sc2, g2 = jnp.split(mod, 6, axis=-1)
        mod_c = jax.nn.silu(c_ctx.astype(f32)) @ w_mod[i][:, :2 * D_MODEL] + b_mod[i][:2 * D_MODEL]
        shc, scc = jnp.split(mod_c, 2)

        h = rms_norm(h_state, norm_mix_pre[i]) * (1.0 + sc1[:, None]) + sh1[:, None]
        hc = rms_norm(ctx, norm_mix_pre[i]) * (1.0 + scc) + shc
        y = hybrid_mixer(h, hc, w_in[i], ret_decay[i], gla_a_up[i], gla_a_bias[i], ret_gn[i], gla_gn[i],
                         w_up_ret[i], w_up_gla[i], w_out[i], cos, sin)
        h_state = h_state + g1[:, None] * rms_norm(y, norm_mix_post[i])

        h = rms_norm(h_state, norm_ffn_pre[i]) * (1.0 + sc2[:, None]) + sh2[:, None]
        y = (jax.nn.silu(h @ ffn_w_gate[i]) * (h @ ffn_w_up[i])) @ ffn_w_down[i]
        h_state = h_state + g2[:, None] * rms_norm(y, norm_ffn_post[i])
    return h_state.astype(out_dtype)
```

```cpp
#include <hip/hip_runtime.h>
#include <hip/hip_cooperative_groups.h>
#include <cstdio>
#include <cstring>
namespace cg = cooperative_groups;

namespace pg8 {
#define PG8_LAS __attribute__((address_space(3)))
typedef unsigned short bf16_t;
typedef short bf16x8 __attribute__((ext_vector_type(8)));
typedef float f32x4 __attribute__((ext_vector_type(4)));
typedef unsigned u32x4 __attribute__((ext_vector_type(4)));
constexpr int BM = 256, BK = 64, HALF = 128, HTB = HALF * BK * 2  , STAGE_BYTES = 8 * HTB, NXCD = 8, WGM = 8;

__host__ __device__ __forceinline__ int lds_byte(int r, int c) { const int st = (r >> 4) * 2 + (c >> 5), rr = r & 15, cc = c & 31, ob = rr * 64 + cc * 2; return st * 1024 + (ob ^ (((ob >> 9) & 1) << 5)); }
__host__ __device__ __forceinline__ void stage_rc(int b, int& R, int& C) { const int st = b / 1024, sb = b % 1024, swz = sb ^ (((sb >> 9) & 1) << 5); R = (st >> 1) * 16 + swz / 64; C = (st & 1) * 32 + (swz % 64) / 2; }
__host__ __device__ __forceinline__ int perm32(int rho) { const int n = rho >> 4, i = rho & 15; return 8 * (i >> 2) + 4 * n + (i & 3); }

struct Unit { int pm, pn; };
struct Gemm { const bf16_t* A; const bf16_t* Bt; int M, N, K; };

struct StaticOrder {
    int nM, nN, nwg, G, c;
    __host__ __device__ void init(int M, int N, int G_, int c_) { nM = M / BM; nN = N / BM; nwg = nM * nN; G = G_; c = c_; }
    __host__ __device__ bool next(int i, Unit& u) const {
        const long L = (long)i * G + c; if (L >= nwg) return false;
        int wgid = (int)L; { const int q = nwg / NXCD, r = nwg % NXCD, xcd = wgid % NXCD, off = wgid / NXCD; wgid = (xcd < r ? xcd * (q + 1) : r * (q + 1) + (xcd - r) * q) + off; }
        const int nig = WGM * nN, gid = wgid / nig, fm = gid * WGM, gsz = (nM - fm) < WGM ? (nM - fm) : WGM;
        u.pm = fm + ((wgid % nig) % gsz); u.pn = (wgid % nig) / gsz; return true;
    }
    __device__ __forceinline__ void a_ready(const Unit&) const {}
    __device__ __forceinline__ void done(const Unit&) const {}
};


template <class Epi, class Sched>
__device__ __forceinline__ void gemm_phase(PG8_LAS unsigned char* lds, const Gemm g, const Sched& S, const Epi& E) {
    const int tid = threadIdx.x, wid = __builtin_amdgcn_readfirstlane(tid >> 6), lane = tid & 63, wr = wid >> 2, wc = wid & 3, fr = lane & 15, fq = lane >> 4;
    const int K = g.K, nt = K / BK;
    unsigned voffA[2], voffB[2];
#pragma unroll
    for (int i = 0; i < 2; ++i) { int R, C; stage_rc(tid * 16 + i * 8192, R, C); const int Rb = Epi::PERM ? ((R & ~31) + perm32(R & 31)) : R;
        voffA[i] = (unsigned)(R * K + C) * 2u; voffB[i] = (unsigned)(Rb * K + C) * 2u; }
    const size_t kstep = (size_t)(BK * 2);
    const size_t hstep = (size_t)HALF * K * 2;
    const size_t tstep = 2 * hstep;
    const unsigned ldsw = (unsigned)wid * 1024u;
    const int aoff = lds_byte(wr * 64 + fr, fq * 8), boff = lds_byte(wc * 32 + fr, fq * 8);
#define PG8_SA(b, h) (((b) * 2 + (h)) * HTB)
#define PG8_SB(b, h) ((4 + (b) * 2 + (h)) * HTB)
#define PG8_STAGE(bufoff, gbase, voff) do { _Pragma("unroll") for (int _i = 0; _i < 2; ++_i) \
        __builtin_amdgcn_global_load_lds((const unsigned*)((const char*)(gbase) + (voff)[_i]), (PG8_LAS unsigned*)(lds + (bufoff) + ldsw + _i * 8192), 16, 0, 0); } while (0)
#define PG8_LDA(dst, b, h) do { _Pragma("unroll") for (int m = 0; m < 4; ++m) _Pragma("unroll") for (int k = 0; k < 2; ++k) dst[m][k] = *(const PG8_LAS bf16x8*)(lds + PG8_SA(b, h) + aoff + m * 2048 + k * 1024); } while (0)
#define PG8_LDB(dst, b, h) do { _Pragma("unroll") for (int n = 0; n < 2; ++n) _Pragma("unroll") for (int k = 0; k < 2; ++k) dst[n][k] = *(const PG8_LAS bf16x8*)(lds + PG8_SB(b, h) + boff + n * 2048 + k * 1024); } while (0)
#define PG8_MMA(ai, bj, At, Bt) do { __builtin_amdgcn_s_setprio(1); _Pragma("unroll") for (int m = 0; m < 4; ++m) _Pragma("unroll") for (int n = 0; n < 2; ++n) _Pragma("unroll") for (int k = 0; k < 2; ++k) \
        acc[ai][bj][m][n] = __builtin_amdgcn_mfma_f32_16x16x32_bf16(Bt[n][k], At[m][k], acc[ai][bj][m][n], 0, 0, 0); __builtin_amdgcn_s_setprio(0); } while (0)
#define PG8_WAIT_V(n) asm volatile("s_waitcnt vmcnt(" #n ")" ::: "memory")
#define PG8_WAIT_L(n) asm volatile("s_waitcnt lgkmcnt(" #n ")" ::: "memory")
#define PG8_BAR __builtin_amdgcn_s_barrier()
#define PG8_SCHED __builtin_amdgcn_sched_barrier(0)
    Unit cur, nxt; int ui = 0;
    if (!S.next(0, cur)) return;
    f32x4 acc[2][2][4][2];
#pragma unroll
    for (int a = 0; a < 2; ++a)
#pragma unroll
        for (int b = 0; b < 2; ++b)
#pragma unroll
            for (int m = 0; m < 4; ++m)
#pragma unroll
                for (int n = 0; n < 2; ++n) acc[a][b][m][n] = (f32x4){0.f, 0.f, 0.f, 0.f};
    bf16x8 At[4][2], B0[2][2], B1[2][2];
    const char* cA = (const char*)g.A + (size_t)cur.pm * tstep; const char* cB = (const char*)g.Bt + (size_t)cur.pn * tstep;
    S.a_ready(cur);
    PG8_STAGE(PG8_SB(0, 0), cB, voffB); PG8_STAGE(PG8_SA(0, 0), cA, voffA); PG8_STAGE(PG8_SB(0, 1), cB + hstep, voffB); PG8_STAGE(PG8_SA(0, 1), cA + hstep, voffA);
    if (wr == 1) PG8_BAR;
    PG8_WAIT_V(4); PG8_BAR;
    PG8_STAGE(PG8_SB(1, 0), cB + kstep, voffB); PG8_STAGE(PG8_SA(1, 0), cA + kstep, voffA); PG8_STAGE(PG8_SB(1, 1), cB + hstep + kstep, voffB);
    PG8_WAIT_V(6); PG8_BAR;
    for (;;) {
        const bool has_next = S.next(ui + 1, nxt);
        const char* nA = has_next ? (const char*)g.A + (size_t)nxt.pm * tstep : cA; const char* nB = has_next ? (const char*)g.Bt + (size_t)nxt.pn * tstep : cB;
        for (int t = 0; t < nt; t += 2) {
            const bool last = (t == nt - 2);
            const char* a1 = cA + (size_t)(t + 1) * kstep;
            const char* a2 = last ? nA : cA + (size_t)(t + 2) * kstep; const char* b2 = last ? nB : cB + (size_t)(t + 2) * kstep;
            const char* a3 = a2 + kstep; const char* b3 = b2 + kstep;
            if (last && has_next) S.a_ready(nxt);
            PG8_LDB(B0, 0, 0); PG8_SCHED; PG8_LDA(At, 0, 0); PG8_STAGE(PG8_SA(1, 1), a1 + hstep, voffA);
            PG8_WAIT_L(8); PG8_BAR; PG8_WAIT_L(0); PG8_MMA(0, 0, At, B0); PG8_BAR; PG8_SCHED;
            PG8_LDB(B1, 0, 1); PG8_STAGE(PG8_SB(0, 0), b2, voffB);
            PG8_BAR; PG8_WAIT_L(0); PG8_MMA(0, 1, At, B1); PG8_BAR;
            PG8_LDA(At, 0, 1); PG8_STAGE(PG8_SA(0, 0), a2, voffA);
            PG8_BAR; PG8_WAIT_L(0); PG8_MMA(1, 0, At, B0); PG8_BAR; PG8_SCHED;
            PG8_STAGE(PG8_SB(0, 1), b2 + hstep, voffB);
            PG8_WAIT_V(6); PG8_BAR; PG8_MMA(1, 1, At, B1); PG8_BAR;
            PG8_LDB(B0, 1, 0); PG8_SCHED; PG8_LDA(At, 1, 0); PG8_STAGE(PG8_SA(0, 1), a2 + hstep, voffA);
            PG8_WAIT_L(8); PG8_BAR; PG8_WAIT_L(0); PG8_MMA(0, 0, At, B0); PG8_BAR; PG8_SCHED;
            PG8_LDB(B1, 1, 1); PG8_STAGE(PG8_SB(1, 0), b3, voffB);
            PG8_BAR; PG8_WAIT_L(0); PG8_MMA(0, 1, At, B1); PG8_BAR;
            PG8_LDA(At, 1, 1); PG8_STAGE(PG8_SA(1, 0), a3, voffA);
            PG8_BAR; PG8_WAIT_L(0); PG8_MMA(1, 0, At, B0); PG8_BAR; PG8_SCHED;
            PG8_STAGE(PG8_SB(1, 1), b3 + hstep, voffB);
            PG8_WAIT_V(6); PG8_BAR; PG8_MMA(1, 1, At, B1); PG8_BAR;
        }
        if constexpr (!Epi::AFTER_DRAIN) { E(acc, cur, wr, wc, fr, fq); S.done(cur); }
        if (!has_next) break;
#pragma unroll
        for (int a = 0; a < 2; ++a)
#pragma unroll
            for (int b = 0; b < 2; ++b)
#pragma unroll
                for (int m = 0; m < 4; ++m)
#pragma unroll
                    for (int n = 0; n < 2; ++n) acc[a][b][m][n] = (f32x4){0.f, 0.f, 0.f, 0.f};
        cur = nxt; cA = nA; cB = nB; ++ui;
    }
    PG8_WAIT_V(0);
    if (wr == 0) PG8_BAR;
    PG8_BAR;
    if constexpr (Epi::AFTER_DRAIN) { E.fused(acc, cur, wr, wc, fr, fq, lds, wid, lane); S.done(cur); }
#undef PG8_SA
#undef PG8_SB
#undef PG8_STAGE
#undef PG8_LDA
#undef PG8_LDB
#undef PG8_MMA
#undef PG8_WAIT_V
#undef PG8_WAIT_L
#undef PG8_BAR
#undef PG8_SCHED
}
}

using pg8::bf16_t; using pg8::bf16x8; using pg8::f32x4; using pg8::u32x4;
#define LAS __attribute__((address_space(3)))
typedef short s16x4 __attribute__((ext_vector_type(4)));
typedef unsigned u32x2 __attribute__((ext_vector_type(2)));

constexpr int D = 2048, NB = 2, SEQ = 4096, NTOK = NB * SEQ, LC = 256, NCTX = NB * LC, MROWS = NTOK + NCTX;
constexpr int DIN = 11296, LDP = 11520, DFF = 5632, NGU = 2 * DFF;
constexpr int C_RK = 0, C_RV = 1024, C_GK = 2048, C_GV = 2560, C_GA = 3584, C_RQ = 3840, C_RG = 4864, C_GQ = 5888, C_GG = 6400, C_GTA = 7424, C_GTB = 9472;
constexpr float EPS = 1e-6f;
constexpr int NTHREADS = 512, LDS_BYTES = 147456;

constexpr size_t WS_W1T = 0;
constexpr size_t WS_HALL = WS_W1T + (size_t)LDP * D * 2;
constexpr size_t WS_OF = WS_W1T, WS_OB = WS_OF + (size_t)NTOK * D * 2, WS_MERGED = WS_W1T;
constexpr size_t WS_WUR = WS_HALL + (size_t)MROWS * D * 2;
constexpr size_t WS_WUG = WS_WUR + (size_t)D * 1024 * 2;
constexpr size_t WS_WOUT = WS_WUG + (size_t)D * 1024 * 2;
constexpr size_t WS_WGU = WS_WOUT + (size_t)D * D * 2;
constexpr size_t WS_WD = WS_WGU + (size_t)NGU * D * 2;
constexpr size_t WS_PALL = WS_WD + (size_t)D * DFF * 2;
constexpr size_t WS_Y = WS_PALL, WS_H2 = WS_Y + (size_t)NTOK * D * 4, WS_ACT = WS_H2 + (size_t)NTOK * D * 2;
constexpr size_t WS_GA = WS_PALL + (size_t)MROWS * LDP * 2;
constexpr size_t WS_MOD = WS_GA + (size_t)MROWS * 32 * 4;
constexpr size_t WS_ROPE = WS_MOD + (size_t)3 * 12288 * 4;
constexpr size_t WS_END = WS_ROPE + 2 * 64 * 64 * 4;
static_assert(WS_OB + (size_t)NTOK * D * 2 <= WS_WUR, "o_f/o_b must fit in the dead W1T+HALL region");
static_assert(WS_ACT + (size_t)NTOK * DFF * 2 <= WS_GA, "y/h2/act must fit in the dead PALL region");

struct Params {
    const float *x, *c, *ctx, *c_ctx, *w_mod, *b_mod, *n_mix_pre, *n_mix_post, *n_ffn_pre, *n_ffn_post, *w_in, *ret_decay, *gla_a_up, *gla_a_bias,
        *ret_gn, *gla_gn, *w_up_ret, *w_up_gla, *w_out, *ffn_g, *ffn_u, *ffn_d;
    float* out; unsigned char* ws; int ph_lo, ph_hi;
};

__device__ __forceinline__ float bf_lo(unsigned u) { return __uint_as_float(u << 16); }
__device__ __forceinline__ float bf_hi(unsigned u) { return __uint_as_float(u & 0xffff0000u); }
typedef __bf16 bf16v2_t __attribute__((ext_vector_type(2)));
typedef float f32v2_t __attribute__((ext_vector_type(2)));
__device__ __forceinline__ unsigned pk2(float lo, float hi) { const f32v2_t f = {lo, hi}; const bf16v2_t b = __builtin_convertvector(f, bf16v2_t); return __builtin_bit_cast(unsigned, b); }
__device__ __forceinline__ float wave_sum(float v) {
#pragma unroll
    for (int o = 1; o < 64; o <<= 1) v += __shfl_xor(v, o);
    return v;
}
__device__ __forceinline__ float sigmoidf_(float v) { return 1.0f / (1.0f + __expf(-v)); }
__device__ __forceinline__ float siluf_(float v) { return v / (1.0f + __expf(-v)); }
#define LDS_WAIT() asm volatile("s_waitcnt lgkmcnt(0)" ::: "memory")

__device__ __forceinline__ void tr_item(const float* __restrict__ W, int K, int N, bf16_t* __restrict__ WT, int drow, LAS float* scr, int k0, int n0, int lane) {
#pragma unroll 8
    for (int i = 0; i < 32; ++i) { const int kk = 2 * i + (lane >> 5); scr[kk * 33 + (lane & 31)] = W[(size_t)(k0 + kk) * N + n0 + (lane & 31)]; }
    LDS_WAIT(); __builtin_amdgcn_wave_barrier();
    const int c = lane & 7;
#pragma unroll
    for (int j = 0; j < 4; ++j) { const int n = (lane >> 3) + 8 * j; const LAS float* s = scr + (8 * c) * 33 + n;
        u32x4 o; o.x = pk2(s[0 * 33], s[1 * 33]); o.y = pk2(s[2 * 33], s[3 * 33]); o.z = pk2(s[4 * 33], s[5 * 33]); o.w = pk2(s[6 * 33], s[7 * 33]);
        *(u32x4*)(WT + (size_t)(drow + n) * K + k0 + 8 * c) = o; }
    LDS_WAIT(); __builtin_amdgcn_wave_barrier();
}

__device__ __forceinline__ void phase0(const Params& P, LAS unsigned char* lds) {
    const int tid = threadIdx.x, lane = tid & 63, wave = tid >> 6, G = gridDim.x;
    unsigned char* ws = P.ws;
    for (int item = blockIdx.x; item < 96; item += G) {
        LAS float* sv = (LAS float*)lds;
        LAS float* red = (LAS float*)(lds + 24576);
        for (int i = tid; i < 3 * 2048; i += NTHREADS) { const int r = i >> 11, k = i & 2047; const float v = r < 2 ? P.c[r * 2048 + k] : P.c_ctx[k]; sv[i] = siluf_(v); }
        __syncthreads();
        const int cq = tid & 31, kg = tid >> 5, n0 = item * 128 + cq * 4;
        f32x4 a0 = {0.f, 0.f, 0.f, 0.f}, a1 = a0, a2 = a0;
#pragma unroll 4
        for (int k = kg; k < 2048; k += 16) { const f32x4 w = *(const f32x4*)(P.w_mod + (size_t)k * 12288 + n0); a0 += sv[k] * w; a1 += sv[2048 + k] * w; a2 += sv[4096 + k] * w; }
#pragma unroll
        for (int j = 0; j < 4; ++j) { red[(kg * 3 + 0) * 128 + cq * 4 + j] = a0[j]; red[(kg * 3 + 1) * 128 + cq * 4 + j] = a1[j]; red[(kg * 3 + 2) * 128 + cq * 4 + j] = a2[j]; }
        __syncthreads();
        if (tid < 384) { const int r = tid >> 7, n = tid & 127; float s = 0.f;
#pragma unroll
            for (int g = 0; g < 16; ++g) s += red[(g * 3 + r) * 128 + n];
            ((float*)(ws + WS_MOD))[r * 12288 + item * 128 + n] = s + P.b_mod[item * 128 + n]; }
        __syncthreads();
    }
    if (blockIdx.x == G - 1) {
        float* rope = (float*)(ws + WS_ROPE);
        for (int e = tid; e < 4096; e += NTHREADS) { const int pos = e >> 6, i = e & 63;
            const float inv = powf(10000.0f, -(float)i / 64.0f); const float ang = (float)pos * inv;
            double rev = (double)ang * 0.15915494309189535; rev -= floor(rev); const float fr = (float)rev;
            rope[e] = __builtin_amdgcn_cosf(fr); rope[4096 + e] = __builtin_amdgcn_sinf(fr); }
    }
    { u32x4* z = (u32x4*)(ws + WS_W1T + (size_t)3616 * D * 2); const u32x4 zero = {0u, 0u, 0u, 0u};
      for (int i = blockIdx.x * NTHREADS + tid; i < 224 * D * 2 / 16; i += G * NTHREADS) z[i] = zero; }
    LAS float* scr = (LAS float*)(lds + wave * 8448);
    constexpr int I1 = 32 * (DIN / 32), IU = 16 * 64, IO = 32 * 64, IG = 32 * (DFF / 32), IDN = (DFF / 64) * 64;
    constexpr int NIT = I1 + 2 * IU + IO + 2 * IG + IDN;
    for (int it = blockIdx.x * 8 + wave; it < NIT; it += G * 8) {
        int r = it;
        if (r < I1) { const int nbk = DIN / 32, kb = r / nbk, nb = r % nbk, n0 = nb * 32; tr_item(P.w_in, D, DIN, (bf16_t*)(ws + WS_W1T), n0 < 3616 ? n0 : n0 + 224, scr, kb * 64, n0, lane); continue; } r -= I1;
        if (r < IU) { const int kb = r / 64, nb = r % 64; tr_item(P.w_up_ret, 1024, D, (bf16_t*)(ws + WS_WUR), nb * 32, scr, kb * 64, nb * 32, lane); continue; } r -= IU;
        if (r < IU) { const int kb = r / 64, nb = r % 64; tr_item(P.w_up_gla, 1024, D, (bf16_t*)(ws + WS_WUG), nb * 32, scr, kb * 64, nb * 32, lane); continue; } r -= IU;
        if (r < IO) { const int kb = r / 64, nb = r % 64; tr_item(P.w_out, D, D, (bf16_t*)(ws + WS_WOUT), nb * 32, scr, kb * 64, nb * 32, lane); continue; } r -= IO;
        if (r < IG) { const int nbk = DFF / 32, kb = r / nbk, nb = r % nbk, n0 = nb * 32; tr_item(P.ffn_g, D, DFF, (bf16_t*)(ws + WS_WGU), (n0 >> 7) * 256 + (n0 & 127), scr, kb * 64, n0, lane); continue; } r -= IG;
        if (r < IG) { const int nbk = DFF / 32, kb = r / nbk, nb = r % nbk, n0 = nb * 32; tr_item(P.ffn_u, D, DFF, (bf16_t*)(ws + WS_WGU), (n0 >> 7) * 256 + 128 + (n0 & 127), scr, kb * 64, n0, lane); continue; } r -= IG;
        { const int kb = r / 64, nb = r % 64; tr_item(P.ffn_d, DFF, D, (bf16_t*)(ws + WS_WD), nb * 32, scr, kb * 64, nb * 32, lane); }
    }
}

__device__ __forceinline__ void phase1(const Params& P) {
    const int tid = threadIdx.x, lane = tid & 63, wave = tid >> 6, G = gridDim.x;
    const float* mod = (const float*)(P.ws + WS_MOD);
    bf16_t* hall = (bf16_t*)(P.ws + WS_HALL);
    for (int row = blockIdx.x * 8 + wave; row < MROWS; row += G * 8) {
        const float* src = row < NTOK ? P.x + (size_t)row * D : P.ctx + (size_t)(row - NTOK) * D;
        const int mr = row < NTOK ? row / SEQ : 2;
        const float* sh = mod + (size_t)mr * 12288; const float* sc = sh + 2048;
        f32x4 v[8]; float ss = 0.f;
#pragma unroll
        for (int j = 0; j < 8; ++j) { v[j] = ((const f32x4*)src)[64 * j + lane]; ss += (v[j].x * v[j].x + v[j].y * v[j].y) + (v[j].z * v[j].z + v[j].w * v[j].w); }
        const float rinv = 1.0f / sqrtf(wave_sum(ss) * (1.0f / D) + EPS);
#pragma unroll
        for (int j = 0; j < 8; ++j) { const int c4 = 64 * j + lane; const f32x4 w = ((const f32x4*)P.n_mix_pre)[c4], s = ((const f32x4*)sc)[c4], h = ((const f32x4*)sh)[c4];
            const f32x4 o = v[j] * rinv * w * (s + 1.0f) + h;
            u32x2 pk; pk.x = pk2(o.x, o.y); pk.y = pk2(o.z, o.w); ((u32x2*)(hall + (size_t)row * D))[c4] = pk; }
    }
}

struct EpiP {
    static constexpr bool PERM = true, AFTER_DRAIN = false;
    bf16_t* O; float* ga;
    __device__ __forceinline__ void operator()(const f32x4 (&acc)[2][2][4][2], const pg8::Unit& u, int wr, int wc, int fr, int fq) const {
        const int row0 = u.pm * 256 + wr * 64 + fr, col0 = u.pn * 256 + wc * 32 + 8 * fq;
#pragma unroll
        for (int ai = 0; ai < 2; ++ai)
#pragma unroll
            for (int m = 0; m < 4; ++m) { bf16_t* rowp = O + (size_t)(row0 + ai * 128 + m * 16) * LDP + col0;
#pragma unroll
                for (int bj = 0; bj < 2; ++bj) { const f32x4 v0 = acc[ai][bj][m][0], v1 = acc[ai][bj][m][1];
                    u32x4 w; w.x = pk2(v0[0], v0[1]); w.y = pk2(v0[2], v0[3]); w.z = pk2(v1[0], v1[1]); w.w = pk2(v1[2], v1[3]);
                    *(u32x4*)(rowp + bj * 128) = w; } }
        if (u.pn == 14 && wc == 0) {
#pragma unroll
            for (int ai = 0; ai < 2; ++ai)
#pragma unroll
                for (int m = 0; m < 4; ++m) { float* g = ga + (size_t)(row0 + ai * 128 + m * 16) * 32 + 8 * fq;
                    *(f32x4*)g = acc[ai][0][m][0]; *(f32x4*)(g + 4) = acc[ai][0][m][1]; }
        }
    }
};
template <int SECOND> struct EpiGate {
    static constexpr bool PERM = true, AFTER_DRAIN = false;
    bf16_t* O; const bf16_t* pall;
    __device__ __forceinline__ void operator()(const f32x4 (&acc)[2][2][4][2], const pg8::Unit& u, int wr, int wc, int fr, int fq) const {
        const int row0 = u.pm * 256 + wr * 64 + fr, col0 = u.pn * 256 + wc * 32 + 8 * fq;
#pragma unroll
        for (int ai = 0; ai < 2; ++ai)
#pragma unroll
            for (int m = 0; m < 4; ++m) { const int row = row0 + ai * 128 + m * 16; bf16_t* rowp = O + (size_t)row * D + col0;
                const bf16_t* gp = pall + (size_t)row * LDP + (SECOND ? C_GTB : C_GTA) + col0;
#pragma unroll
                for (int bj = 0; bj < 2; ++bj) { const f32x4 v0 = acc[ai][bj][m][0], v1 = acc[ai][bj][m][1];
                    const u32x4 g = *(const u32x4*)(gp + bj * 128);
                    float r[8];
                    r[0] = sigmoidf_(bf_lo(g.x)) * v0[0]; r[1] = sigmoidf_(bf_hi(g.x)) * v0[1]; r[2] = sigmoidf_(bf_lo(g.y)) * v0[2]; r[3] = sigmoidf_(bf_hi(g.y)) * v0[3];
                    r[4] = sigmoidf_(bf_lo(g.z)) * v1[0]; r[5] = sigmoidf_(bf_hi(g.z)) * v1[1]; r[6] = sigmoidf_(bf_lo(g.w)) * v1[2]; r[7] = sigmoidf_(bf_hi(g.w)) * v1[3];
                    if (SECOND) { const u32x4 p = *(const u32x4*)(rowp + bj * 128);
                        r[0] += bf_lo(p.x); r[1] += bf_hi(p.x); r[2] += bf_lo(p.y); r[3] += bf_hi(p.y); r[4] += bf_lo(p.z); r[5] += bf_hi(p.z); r[6] += bf_lo(p.w); r[7] += bf_hi(p.w); }
                    u32x4 w; w.x = pk2(r[0], r[1]); w.y = pk2(r[2], r[3]); w.z = pk2(r[4], r[5]); w.w = pk2(r[6], r[7]);
                    *(u32x4*)(rowp + bj * 128) = w; } }
    }
};
struct EpiF32 {
    static constexpr bool PERM = false, AFTER_DRAIN = false;
    float* C; int ldc;
    __device__ __forceinline__ void operator()(const f32x4 (&acc)[2][2][4][2], const pg8::Unit& u, int wr, int wc, int fr, int fq) const {
        const int row0 = u.pm * 256 + wr * 64 + fr, col0 = u.pn * 256 + wc * 32 + 4 * fq;
#pragma unroll
        for (int ai = 0; ai < 2; ++ai)
#pragma unroll
            for (int m = 0; m < 4; ++m) { float* rowp = C + (size_t)(row0 + ai * 128 + m * 16) * ldc + col0;
#pragma unroll
                for (int bj = 0; bj < 2; ++bj)
#pragma unroll
                    for (int n = 0; n < 2; ++n) *(f32x4*)(rowp + bj * 128 + n * 16) = acc[ai][bj][m][n]; }
    }
};
struct EpiSwiGLU {
    static constexpr bool PERM = true, AFTER_DRAIN = false;
    bf16_t* O;
    __device__ __forceinline__ void operator()(const f32x4 (&acc)[2][2][4][2], const pg8::Unit& u, int wr, int wc, int fr, int fq) const {
        const int row0 = u.pm * 256 + wr * 64 + fr, col0 = u.pn * 128 + wc * 32 + 8 * fq;
#pragma unroll
        for (int ai = 0; ai < 2; ++ai)
#pragma unroll
            for (int m = 0; m < 4; ++m) { bf16_t* rowp = O + (size_t)(row0 + ai * 128 + m * 16) * DFF + col0;
                const f32x4 g0 = acc[ai][0][m][0], g1 = acc[ai][0][m][1], u0 = acc[ai][1][m][0], u1 = acc[ai][1][m][1];
                u32x4 w; w.x = pk2(siluf_(g0[0]) * u0[0], siluf_(g0[1]) * u0[1]); w.y = pk2(siluf_(g0[2]) * u0[2], siluf_(g0[3]) * u0[3]);
                w.z = pk2(siluf_(g1[0]) * u1[0], siluf_(g1[1]) * u1[1]); w.w = pk2(siluf_(g1[2]) * u1[2], siluf_(g1[3]) * u1[3]);
                *(u32x4*)rowp = w; }
    }
};

__device__ __forceinline__ bf16x8 tr_frag(LAS unsigned char* X, int pitchB, int k0, int c0, int lane) {
    const int i = lane & 15, Q = lane >> 4;
    const int off = (k0 + Q * 8 + (i >> 2)) * pitchB + (c0 + 4 * (i & 3)) * 2;
    const s16x4 lo = __builtin_amdgcn_ds_read_tr16_b64_v4i16((LAS s16x4*)(X + off));
    const s16x4 hi = __builtin_amdgcn_ds_read_tr16_b64_v4i16((LAS s16x4*)(X + off + 4 * pitchB));
    bf16x8 r; r[0] = lo[0]; r[1] = lo[1]; r[2] = lo[2]; r[3] = lo[3]; r[4] = hi[0]; r[5] = hi[1]; r[6] = hi[2]; r[7] = hi[3]; return r;
}
#define MFMA16(a, b, c) __builtin_amdgcn_mfma_f32_16x16x32_bf16(a, b, c, 0, 0, 0)

template <int DK, bool RET>
__device__ __forceinline__ void chain_run(const Params& P, int chain, LAS unsigned char* lds) {
    constexpr int PQ = (DK + 8) * 2, PV = 80, PP = 144;
    constexpr int O_QD = 0, O_KD = O_QD + 64 * PQ, O_VV = O_KD + 64 * PQ, O_PP = O_VV + 64 * PV, O_ST = O_PP + 64 * PP, O_EL = O_ST + 32 * PQ, O_X = O_EL + DK * 4;
    constexpr int MT = DK / 128;
    const int tid = threadIdx.x, lane = tid & 63, wave = tid >> 6, l15 = lane & 15, quad = lane >> 4;
    const int s = chain & 7, dir = (chain >> 3) & 1, h = (chain >> 4) & 3, b = chain >> 6;
    const bf16_t* pall = (const bf16_t*)(P.ws + WS_PALL);
    const int kcol = RET ? C_RK + h * 256 : C_GK + h * 128, qcol = RET ? C_RQ + h * 256 : C_GQ + h * 128, vcol = (RET ? C_RV : C_GV) + h * 256 + s * 32;
    bf16_t* obase = (bf16_t*)(P.ws + (dir ? WS_OB : WS_OF)) + (RET ? 0 : 1024) + h * 256 + s * 32;
    LAS unsigned char* QD = lds + O_QD; LAS unsigned char* KD = lds + O_KD; LAS unsigned char* VV = lds + O_VV; LAS unsigned char* PPb = lds + O_PP; LAS unsigned char* ST = lds + O_ST;
    LAS float* EL = (LAS float*)(lds + O_EL);
    for (int i = tid; i < 32 * PQ / 4; i += NTHREADS) ((LAS unsigned*)ST)[i] = 0u;
    float lg = 0.f;
    float aup0[16], aup1[16], bias0 = 0.f, bias1 = 0.f;
    LAS float* ROPE = (LAS float*)(lds + O_X);
    LAS float* GAc = (LAS float*)(lds + O_X);
    LAS float* TOT = (LAS float*)(lds + O_X + 4096);
    const int dp = tid & 63, tg = tid >> 6;
    if (RET) {
        lg = -__expf(P.ret_decay[dir * 4 + h]);
        const float* rope = (const float*)(P.ws + WS_ROPE);
        for (int i = tid; i < 8192; i += NTHREADS) ROPE[i] = rope[i];
        if (tid < DK) EL[tid] = __expf(64.0f * lg);
    } else {
#pragma unroll
        for (int r = 0; r < 16; ++r) { aup0[r] = P.gla_a_up[(size_t)(dir * 16 + r) * 512 + h * 128 + 2 * dp]; aup1[r] = P.gla_a_up[(size_t)(dir * 16 + r) * 512 + h * 128 + 2 * dp + 1]; }
        bias0 = P.gla_a_bias[dir * 512 + h * 128 + 2 * dp]; bias1 = P.gla_a_bias[dir * 512 + h * 128 + 2 * dp + 1];
    }
    f32x4 sacc[MT][2];
#pragma unroll
    for (int a = 0; a < MT; ++a) { sacc[a][0] = (f32x4){0.f, 0.f, 0.f, 0.f}; sacc[a][1] = (f32x4){0.f, 0.f, 0.f, 0.f}; }
    __syncthreads();

    for (int step = 0; step < 68; ++step) {
        const bool isctx = step < 4;
        const int cidx = isctx ? (dir ? 3 - step : step) : (dir ? 63 - (step - 4) : step - 4);
        const int rowbase = isctx ? NTOK + b * LC + cidx * 64 : b * SEQ + cidx * 64;
        if (RET) {
#pragma unroll
            for (int u = 0; u < 2; ++u) {
                const int item = tid + NTHREADS * u, t = item >> 4, d0 = (item & 15) * 8;
                const bf16_t* rp = pall + (size_t)(rowbase + t) * LDP;
                const float bt = (dir ? (float)(64 - t) : (float)(t + 1)) * lg;
                const float sk = __expf(-bt), sq = 0.0625f * __expf(bt);
                const u32x4 ka = *(const u32x4*)(rp + kcol + d0), kb = *(const u32x4*)(rp + kcol + 128 + d0);
                if (isctx) {
                    u32x4 o1, o2;
                    o1.x = pk2(bf_lo(ka.x) * sk, bf_hi(ka.x) * sk); o1.y = pk2(bf_lo(ka.y) * sk, bf_hi(ka.y) * sk); o1.z = pk2(bf_lo(ka.z) * sk, bf_hi(ka.z) * sk); o1.w = pk2(bf_lo(ka.w) * sk, bf_hi(ka.w) * sk);
                    o2.x = pk2(bf_lo(kb.x) * sk, bf_hi(kb.x) * sk); o2.y = pk2(bf_lo(kb.y) * sk, bf_hi(kb.y) * sk); o2.z = pk2(bf_lo(kb.z) * sk, bf_hi(kb.z) * sk); o2.w = pk2(bf_lo(kb.w) * sk, bf_hi(kb.w) * sk);
                    *(LAS u32x4*)(KD + t * PQ + d0 * 2) = o1; *(LAS u32x4*)(KD + t * PQ + (128 + d0) * 2) = o2;
                } else {
                    const u32x4 qa = *(const u32x4*)(rp + qcol + d0), qb = *(const u32x4*)(rp + qcol + 128 + d0);
                    const int pos = d0 < 64 ? cidx : t, i0 = d0 & 63;
                    const f32x4 c0 = *(LAS f32x4*)(ROPE + pos * 64 + i0), c1 = *(LAS f32x4*)(ROPE + pos * 64 + i0 + 4);
                    const f32x4 s0 = *(LAS f32x4*)(ROPE + 4096 + pos * 64 + i0), s1 = *(LAS f32x4*)(ROPE + 4096 + pos * 64 + i0 + 4);
                    const float cs[8] = {c0.x, c0.y, c0.z, c0.w, c1.x, c1.y, c1.z, c1.w}, sn[8] = {s0.x, s0.y, s0.z, s0.w, s1.x, s1.y, s1.z, s1.w};
                    const unsigned kaw[4] = {ka.x, ka.y, ka.z, ka.w}, kbw[4] = {kb.x, kb.y, kb.z, kb.w}, qaw[4] = {qa.x, qa.y, qa.z, qa.w}, qbw[4] = {qb.x, qb.y, qb.z, qb.w};
                    unsigned k1[4], k2[4], q1[4], q2[4];
#pragma unroll
                    for (int e = 0; e < 4; ++e) {
                        const float ca = cs[2 * e], cb = cs[2 * e + 1], sa = sn[2 * e], sb = sn[2 * e + 1];
                        float t1a = bf_lo(kaw[e]), t1b = bf_hi(kaw[e]), t2a = bf_lo(kbw[e]), t2b = bf_hi(kbw[e]);
                        k1[e] = pk2((t1a * ca - t2a * sa) * sk, (t1b * cb - t2b * sb) * sk); k2[e] = pk2((t1a * sa + t2a * ca) * sk, (t1b * sb + t2b * cb) * sk);
                        t1a = bf_lo(qaw[e]); t1b = bf_hi(qaw[e]); t2a = bf_lo(qbw[e]); t2b = bf_hi(qbw[e]);
                        q1[e] = pk2((t1a * ca - t2a * sa) * sq, (t1b * cb - t2b * sb) * sq); q2[e] = pk2((t1a * sa + t2a * ca) * sq, (t1b * sb + t2b * cb) * sq);
                    }
                    *(LAS u32x4*)(KD + t * PQ + d0 * 2) = (u32x4){k1[0], k1[1], k1[2], k1[3]}; *(LAS u32x4*)(KD + t * PQ + (128 + d0) * 2) = (u32x4){k2[0], k2[1], k2[2], k2[3]};
                    *(LAS u32x4*)(QD + t * PQ + d0 * 2) = (u32x4){q1[0], q1[1], q1[2], q1[3]}; *(LAS u32x4*)(QD + t * PQ + (128 + d0) * 2) = (u32x4){q2[0], q2[1], q2[2], q2[3]};
                }
            }
            if (tid < 256) { const int t = tid >> 2, part = tid & 3; *(LAS u32x4*)(VV + t * PV + part * 16) = *(const u32x4*)(pall + (size_t)(rowbase + t) * LDP + vcol + part * 8); }
        } else {
            unsigned qv[8], kv[8];
#pragma unroll
            for (int j = 0; j < 8; ++j) { const bf16_t* rp = pall + (size_t)(rowbase + tg * 8 + j) * LDP; kv[j] = *(const unsigned*)(rp + kcol + 2 * dp); qv[j] = isctx ? 0u : *(const unsigned*)(rp + qcol + 2 * dp); }
            if (tid < 256) { const int t = tid >> 2, part = tid & 3; *(LAS u32x4*)(VV + t * PV + part * 16) = *(const u32x4*)(pall + (size_t)(rowbase + t) * LDP + vcol + part * 8);
                *(LAS f32x4*)(GAc + t * 16 + part * 4) = *(const f32x4*)((const float*)(P.ws + WS_GA) + (size_t)(rowbase + t) * 32 + dir * 16 + part * 4); }
            __syncthreads();
            float b0[8], b1[8];
#pragma unroll
            for (int j = 0; j < 8; ++j) { const LAS float* g = GAc + (tg * 8 + j) * 16; float z0 = bias0, z1 = bias1;
#pragma unroll
                for (int r = 0; r < 16; ++r) { const float gv = g[r]; z0 += gv * aup0[r]; z1 += gv * aup1[r]; }
                b0[j] = (fminf(z0, 0.f) - __logf(1.0f + __expf(-fabsf(z0)))) * 0.0625f; b1[j] = (fminf(z1, 0.f) - __logf(1.0f + __expf(-fabsf(z1)))) * 0.0625f; }
            float r0 = 0.f, r1 = 0.f;
            if (dir == 0) {
#pragma unroll
                for (int j = 0; j < 8; ++j) { r0 += b0[j]; b0[j] = r0; r1 += b1[j]; b1[j] = r1; }
            } else {
#pragma unroll
                for (int j = 7; j >= 0; --j) { r0 += b0[j]; b0[j] = r0; r1 += b1[j]; b1[j] = r1; }
            }
            TOT[tg * 128 + 2 * dp] = r0; TOT[tg * 128 + 2 * dp + 1] = r1;
            __syncthreads();
            float off0 = 0.f, off1 = 0.f, tot0 = 0.f, tot1 = 0.f;
#pragma unroll
            for (int g = 0; g < 8; ++g) { const float a0 = TOT[g * 128 + 2 * dp], a1 = TOT[g * 128 + 2 * dp + 1]; tot0 += a0; tot1 += a1;
                const bool inc = dir == 0 ? (g < tg) : (g > tg); off0 += inc ? a0 : 0.f; off1 += inc ? a1 : 0.f; }
#pragma unroll
            for (int j = 0; j < 8; ++j) { const int t = tg * 8 + j; const float e0 = b0[j] + off0, e1 = b1[j] + off1;
                *(LAS unsigned*)(KD + t * PQ + 4 * dp) = pk2(bf_lo(kv[j]) * __expf(-e0), bf_hi(kv[j]) * __expf(-e1));
                if (!isctx) *(LAS unsigned*)(QD + t * PQ + 4 * dp) = pk2(bf_lo(qv[j]) * (0.08838834764831845f * __expf(e0)), bf_hi(qv[j]) * (0.08838834764831845f * __expf(e1))); }
            if (tg == 0) { EL[2 * dp] = __expf(tot0); EL[2 * dp + 1] = __expf(tot1); }
        }
        __syncthreads();
        f32x4 oacc = {0.f, 0.f, 0.f, 0.f};
        const int ti = wave >> 1, tn = wave & 1;
        if (!isctx) {
            const int tj0 = (wave & 1) * 2;
            f32x4 p0 = {0.f, 0.f, 0.f, 0.f}, p1 = p0;
#pragma unroll
            for (int k0 = 0; k0 < DK; k0 += 32) {
                const bf16x8 a = *(LAS bf16x8*)(QD + (ti * 16 + l15) * PQ + (k0 + quad * 8) * 2);
                const bf16x8 k0f = *(LAS bf16x8*)(KD + (tj0 * 16 + l15) * PQ + (k0 + quad * 8) * 2);
                const bf16x8 k1f = *(LAS bf16x8*)(KD + ((tj0 + 1) * 16 + l15) * PQ + (k0 + quad * 8) * 2);
                const bf16x8 sf = *(LAS bf16x8*)(ST + (tn * 16 + l15) * PQ + (k0 + quad * 8) * 2);
                p0 = MFMA16(a, k0f, p0); p1 = MFMA16(a, k1f, p1); oacc = MFMA16(a, sf, oacc);
            }
#pragma unroll
            for (int r = 0; r < 4; ++r) { const int i = ti * 16 + quad * 4 + r, j0 = tj0 * 16 + l15, j1 = j0 + 16;
                const bool m0 = dir ? (j0 > i) : (j0 <= i), m1 = dir ? (j1 > i) : (j1 <= i);
                const unsigned w0 = pk2(m0 ? p0[r] : 0.f, 0.f), w1 = pk2(m1 ? p1[r] : 0.f, 0.f);
                *(LAS unsigned short*)(PPb + i * PP + j0 * 2) = (unsigned short)w0; *(LAS unsigned short*)(PPb + i * PP + j1 * 2) = (unsigned short)w1; }
        }
        __syncthreads();
        const bf16x8 vf0a = tr_frag(VV, PV, 0, 0, lane), vf0b = tr_frag(VV, PV, 32, 0, lane), vf1a = tr_frag(VV, PV, 0, 16, lane), vf1b = tr_frag(VV, PV, 32, 16, lane);
        if (!isctx) {
            const bf16x8 pa = *(LAS bf16x8*)(PPb + (ti * 16 + l15) * PP + (quad * 8) * 2), pb = *(LAS bf16x8*)(PPb + (ti * 16 + l15) * PP + (32 + quad * 8) * 2);
            oacc = MFMA16(pa, tn ? vf1a : vf0a, oacc); oacc = MFMA16(pb, tn ? vf1b : vf0b, oacc);
#pragma unroll
            for (int r = 0; r < 4; ++r) { const int i = ti * 16 + quad * 4 + r; obase[(size_t)(rowbase + i) * D + tn * 16 + l15] = (bf16_t)(pk2(oacc[r], 0.f) & 0xffffu); }
        }
#pragma unroll
        for (int a = 0; a < MT; ++a) { const int mt = wave * MT + a;
            const bf16x8 ka = tr_frag(KD, PQ, 0, mt * 16, lane), kb = tr_frag(KD, PQ, 32, mt * 16, lane);
            sacc[a][0] = MFMA16(ka, vf0a, sacc[a][0]); sacc[a][0] = MFMA16(kb, vf0b, sacc[a][0]);
            sacc[a][1] = MFMA16(ka, vf1a, sacc[a][1]); sacc[a][1] = MFMA16(kb, vf1b, sacc[a][1]);
            const f32x4 el = *(LAS f32x4*)(EL + mt * 16 + quad * 4);
            sacc[a][0] *= el; sacc[a][1] *= el;
            u32x2 w0, w1; w0.x = pk2(sacc[a][0][0], sacc[a][0][1]); w0.y = pk2(sacc[a][0][2], sacc[a][0][3]); w1.x = pk2(sacc[a][1][0], sacc[a][1][1]); w1.y = pk2(sacc[a][1][2], sacc[a][1][3]);
            *(LAS u32x2*)(ST + (l15) * PQ + (mt * 16 + quad * 4) * 2) = w0; *(LAS u32x2*)(ST + (16 + l15) * PQ + (mt * 16 + quad * 4) * 2) = w1; }
        __syncthreads();
    }
}

__device__ __forceinline__ void phase3(const Params& P, LAS unsigned char* lds) {
    for (int blk = blockIdx.x; blk < 256; blk += gridDim.x) {
        const int x = blk & 7, y = blk >> 3, grp = x * 4 + (y >> 3), s = y & 7, idx = grp >> 1;
        const int chain = (idx << 3) | s;
        if (grp & 1) chain_run<128, false>(P, chain, lds); else chain_run<256, true>(P, chain, lds);
        __syncthreads();
    }
}

__device__ __forceinline__ void phase4(const Params& P) {
    const int tid = threadIdx.x, lane = tid & 63, wave = tid >> 6, G = gridDim.x;
    const bf16_t* of = (const bf16_t*)(P.ws + WS_OF); const bf16_t* ob = (const bf16_t*)(P.ws + WS_OB); const bf16_t* pall = (const bf16_t*)(P.ws + WS_PALL);
    bf16_t* onr = (bf16_t*)P.out; bf16_t* ong = onr + (size_t)NTOK * 1024;
    for (int T = blockIdx.x * 8 + wave; T < NTOK; T += G * 8) {
#pragma unroll
        for (int hh = 0; hh < 8; ++hh) {
            const int col = hh * 256 + lane * 4;
            const u32x2 a = *(const u32x2*)(of + (size_t)T * D + col), bb = *(const u32x2*)(ob + (size_t)T * D + col);
            float v[4] = {bf_lo(a.x) + bf_lo(bb.x), bf_hi(a.x) + bf_hi(bb.x), bf_lo(a.y) + bf_lo(bb.y), bf_hi(a.y) + bf_hi(bb.y)};
            const bool ret = hh < 4; const int hc = (hh & 3) * 256 + lane * 4;
            const u32x2 gt = *(const u32x2*)(pall + (size_t)T * LDP + (ret ? C_RG : C_GG) + hc);
            const f32x4 gn = *(const f32x4*)((ret ? P.ret_gn : P.gla_gn) + hc);
            float rs;
            if (ret) { const float mean = wave_sum((v[0] + v[1]) + (v[2] + v[3])) * (1.0f / 256.0f);
#pragma unroll
                for (int e = 0; e < 4; ++e) v[e] -= mean; }
            rs = 1.0f / sqrtf(wave_sum((v[0] * v[0] + v[1] * v[1]) + (v[2] * v[2] + v[3] * v[3])) * (1.0f / 256.0f) + EPS);
            u32x2 o; o.x = pk2(v[0] * rs * gn.x * siluf_(bf_lo(gt.x)), v[1] * rs * gn.y * siluf_(bf_hi(gt.x))); o.y = pk2(v[2] * rs * gn.z * siluf_(bf_lo(gt.y)), v[3] * rs * gn.w * siluf_(bf_hi(gt.y)));
            *(u32x2*)((ret ? onr : ong) + (size_t)T * 1024 + hc) = o;
        }
    }
}

__device__ __forceinline__ void phase7(const Params& P) {
    const int tid = threadIdx.x, lane = tid & 63, wave = tid >> 6, G = gridDim.x;
    const float* mod = (const float*)(P.ws + WS_MOD); const float* Y = (const float*)(P.ws + WS_Y); bf16_t* h2 = (bf16_t*)(P.ws + WS_H2);
    for (int row = blockIdx.x * 8 + wave; row < NTOK; row += G * 8) {
        const float* mb = mod + (size_t)(row / SEQ) * 12288;
        f32x4 v[8]; float ss = 0.f;
#pragma unroll
        for (int j = 0; j < 8; ++j) { v[j] = ((const f32x4*)(Y + (size_t)row * D))[64 * j + lane]; ss += (v[j].x * v[j].x + v[j].y * v[j].y) + (v[j].z * v[j].z + v[j].w * v[j].w); }
        const float rinv = 1.0f / sqrtf(wave_sum(ss) * (1.0f / D) + EPS);
        float ss2 = 0.f;
#pragma unroll
        for (int j = 0; j < 8; ++j) { const int c4 = 64 * j + lane; const f32x4 xv = ((const f32x4*)(P.x + (size_t)row * D))[c4], w = ((const f32x4*)P.n_mix_post)[c4], g1 = ((const f32x4*)(mb + 4096))[c4];
            v[j] = xv + g1 * (v[j] * rinv * w); ((f32x4*)(P.out + (size_t)row * D))[c4] = v[j];
            ss2 += (v[j].x * v[j].x + v[j].y * v[j].y) + (v[j].z * v[j].z + v[j].w * v[j].w); }
        const float rinv2 = 1.0f / sqrtf(wave_sum(ss2) * (1.0f / D) + EPS);
#pragma unroll
        for (int j = 0; j < 8; ++j) { const int c4 = 64 * j + lane; const f32x4 w = ((const f32x4*)P.n_ffn_pre)[c4], sh = ((const f32x4*)(mb + 6144))[c4], sc = ((const f32x4*)(mb + 8192))[c4];
            const f32x4 o = v[j] * rinv2 * w * (sc + 1.0f) + sh;
            u32x2 pk; pk.x = pk2(o.x, o.y); pk.y = pk2(o.z, o.w); ((u32x2*)(h2 + (size_t)row * D))[c4] = pk; }
    }
}
__device__ __forceinline__ void phase10(const Params& P) {
    const int tid = threadIdx.x, lane = tid & 63, wave = tid >> 6, G = gridDim.x;
    const float* mod = (const float*)(P.ws + WS_MOD); const float* Y = (const float*)(P.ws + WS_Y);
    for (int row = blockIdx.x * 8 + wave; row < NTOK; row += G * 8) {
        const float* mb = mod + (size_t)(row / SEQ) * 12288;
        f32x4 v[8]; float ss = 0.f;
#pragma unroll
        for (int j = 0; j < 8; ++j) { v[j] = ((const f32x4*)(Y + (size_t)row * D))[64 * j + lane]; ss += (v[j].x * v[j].x + v[j].y * v[j].y) + (v[j].z * v[j].z + v[j].w * v[j].w); }
        const float rinv = 1.0f / sqrtf(wave_sum(ss) * (1.0f / D) + EPS);
#pragma unroll
        for (int j = 0; j < 8; ++j) { const int c4 = 64 * j + lane; f32x4* op = (f32x4*)(P.out + (size_t)row * D) + c4; const f32x4 hs = *op, w = ((const f32x4*)P.n_ffn_post)[c4], g2 = ((const f32x4*)(mb + 10240))[c4];
            *op = hs + g2 * (v[j] * rinv * w); }
    }
}

__global__ __launch_bounds__(512, 2) void hybrid_block_fwd(Params P) {
    extern __shared__ __attribute__((aligned(16))) unsigned char shm[];
    LAS unsigned char* lds = (LAS unsigned char*)shm;
    cg::grid_group grid = cg::this_grid();
    unsigned char* ws = P.ws;
    const int G = gridDim.x, c = blockIdx.x;
#define PHASE(n, ...) if (P.ph_lo <= (n) && (n) < P.ph_hi) { __VA_ARGS__; if ((n) + 1 < P.ph_hi) { asm volatile("s_waitcnt vmcnt(0)" ::: "memory"); grid.sync(); } }
    PHASE(0, phase0(P, lds))
    PHASE(1, phase1(P))
    PHASE(2, { pg8::Gemm g{(const bf16_t*)(ws + WS_HALL), (const bf16_t*)(ws + WS_W1T), MROWS, LDP, D}; pg8::StaticOrder S; S.init(MROWS, LDP, G, c);
               EpiP E{(bf16_t*)(ws + WS_PALL), (float*)(ws + WS_GA)}; pg8::gemm_phase(lds, g, S, E); })
    PHASE(3, phase3(P, lds))
    PHASE(4, phase4(P))
    PHASE(5, { pg8::StaticOrder S; S.init(NTOK, D, G, c);
               { pg8::Gemm g{(const bf16_t*)P.out, (const bf16_t*)(ws + WS_WUR), NTOK, D, 1024}; EpiGate<0> E{(bf16_t*)(ws + WS_MERGED), (const bf16_t*)(ws + WS_PALL)}; pg8::gemm_phase(lds, g, S, E); }
               { pg8::Gemm g{(const bf16_t*)P.out + (size_t)NTOK * 1024, (const bf16_t*)(ws + WS_WUG), NTOK, D, 1024}; EpiGate<1> E{(bf16_t*)(ws + WS_MERGED), (const bf16_t*)(ws + WS_PALL)}; pg8::gemm_phase(lds, g, S, E); } })
    PHASE(6, { pg8::Gemm g{(const bf16_t*)(ws + WS_MERGED), (const bf16_t*)(ws + WS_WOUT), NTOK, D, D}; pg8::StaticOrder S; S.init(NTOK, D, G, c);
               EpiF32 E{(float*)(ws + WS_Y), D}; pg8::gemm_phase(lds, g, S, E); })
    PHASE(7, phase7(P))
    PHASE(8, { pg8::Gemm g{(const bf16_t*)(ws + WS_H2), (const bf16_t*)(ws + WS_WGU), NTOK, NGU, D}; pg8::StaticOrder S; S.init(NTOK, NGU, G, c);
               EpiSwiGLU E{(bf16_t*)(ws + WS_ACT)}; pg8::gemm_phase(lds, g, S, E); })
    PHASE(9, { pg8::Gemm g{(const bf16_t*)(ws + WS_ACT), (const bf16_t*)(ws + WS_WD), NTOK, D, DFF}; pg8::StaticOrder S; S.init(NTOK, D, G, c);
               EpiF32 E{(float*)(ws + WS_Y), D}; pg8::gemm_phase(lds, g, S, E); })
    PHASE(10, phase10(P))
#undef PHASE
}

#ifndef N_LAUNCH_MODE
#define N_LAUNCH_MODE 1
#endif
extern "C" void kernel_launch(void* const* d_in, const int* in_sizes, int n_in, void* d_out, int out_size, void* d_ws, size_t ws_size, hipStream_t stream) {
    static int grid = 0;
    if (grid == 0) {
        if (n_in != 22 || out_size != NTOK * D || ws_size < WS_END) { fprintf(stderr, "kernel_launch: unexpected sizes (n_in %d out %d ws %zu need %zu)\n", n_in, out_size, ws_size, (size_t)WS_END); grid = -1; return; }
        int dev = 0, cus = 0, per_cu = 0;
        hipGetDevice(&dev); hipDeviceGetAttribute(&cus, hipDeviceAttributeMultiprocessorCount, dev);
        if (hipFuncSetAttribute((const void*)hybrid_block_fwd, hipFuncAttributeMaxDynamicSharedMemorySize, LDS_BYTES) != hipSuccess) { fprintf(stderr, "kernel_launch: hipFuncSetAttribute failed\n"); grid = -1; return; }
        if (hipOccupancyMaxActiveBlocksPerMultiprocessor(&per_cu, (const void*)hybrid_block_fwd, NTHREADS, LDS_BYTES) != hipSuccess || per_cu < 1) { fprintf(stderr, "kernel_launch: occupancy query says %d\n", per_cu); (void)hipGetLastError(); per_cu = 1; }
        grid = cus * 1;
        fprintf(stderr, "kernel_launch: grid %d (cus %d, per_cu %d)\n", grid, cus, per_cu);
    }
    if (grid < 0) return;
    Params p; memset(&p, 0, sizeof(p));
    const float** pp = (const float**)&p;
    for (int i = 0; i < 22; ++i) pp[i] = (const float*)d_in[i];
    p.out = (float*)d_out; p.ws = (unsigned char*)d_ws;
#if N_LAUNCH_MODE == 1
    p.ph_lo = 0; p.ph_hi = 11;
    { void* args[] = {&p}; hipError_t e = hipLaunchCooperativeKernel((void*)hybrid_block_fwd, dim3(grid), dim3(NTHREADS), args, LDS_BYTES, stream);
      if (e != hipSuccess) fprintf(stderr, "cooperative launch failed: %s (grid %d)\n", hipGetErrorString(e), grid); }
#else
    for (int ph = 0; ph < 11; ++ph) { p.ph_lo = ph; p.ph_hi = ph + 1; void* args[] = {&p};
        hipError_t e = hipLaunchCooperativeKernel((void*)hybrid_block_fwd, dim3(grid), dim3(NTHREADS), args, LDS_BYTES, stream);
        if (e != hipSuccess) fprintf(stderr, "cooperative launch %d failed: %s (grid %d)\n", ph, hipGetErrorString(e), grid); }
#endif
}
```

```cpp
#include <hip/hip_runtime.h>
#include <hip/hip_cooperative_groups.h>
#include <cstdio>
#include <cstring>
namespace cg = cooperative_groups;

namespace pg8 {
#define PG8_LAS __attribute__((address_space(3)))
typedef unsigned short bf16_t;
typedef short bf16x8 __attribute__((ext_vector_type(8)));
typedef float f32x4 __attribute__((ext_vector_type(4)));
typedef unsigned u32x4 __attribute__((ext_vector_type(4)));
constexpr int BM = 256, BK = 64, HALF = 128, HTB = HALF * BK * 2  , STAGE_BYTES = 8 * HTB, NXCD = 8, WGM = 8;

__host__ __device__ __forceinline__ int lds_byte(int r, int c) { const int st = (r >> 4) * 2 + (c >> 5), rr = r & 15, cc = c & 31, ob = rr * 64 + cc * 2; return st * 1024 + (ob ^ (((ob >> 9) & 1) << 5)); }
__host__ __device__ __forceinline__ void stage_rc(int b, int& R, int& C) { const int st = b / 1024, sb = b % 1024, swz = sb ^ (((sb >> 9) & 1) << 5); R = (st >> 1) * 16 + swz / 64; C = (st & 1) * 32 + (swz % 64) / 2; }
__host__ __device__ __forceinline__ int perm32(int rho) { const int n = rho >> 4, i = rho & 15; return 8 * (i >> 2) + 4 * n + (i & 3); }

struct Unit { int pm, pn; };
struct Gemm { const bf16_t* A; const bf16_t* Bt; int M, N, K; };

struct StaticOrder {
    int nM, nN, nwg, G, c;
    __host__ __device__ void init(int M, int N, int G_, int c_) { nM = M / BM; nN = N / BM; nwg = nM * nN; G = G_; c = c_; }
    __host__ __device__ bool next(int i, Unit& u) const {
        const long L = (long)i * G + c; if (L >= nwg) return false;
        int wgid = (int)L; { const int q = nwg / NXCD, r = nwg % NXCD, xcd = wgid % NXCD, off = wgid / NXCD; wgid = (xcd < r ? xcd * (q + 1) : r * (q + 1) + (xcd - r) * q) + off; }
        const int nig = WGM * nN, gid = wgid / nig, fm = gid * WGM, gsz = (nM - fm) < WGM ? (nM - fm) : WGM;
        u.pm = fm + ((wgid % nig) % gsz); u.pn = (wgid % nig) / gsz; return true;
    }
    __device__ __forceinline__ void a_ready(const Unit&) const {}
    __device__ __forceinline__ void done(const Unit&) const {}
};


template <class Epi, class Sched>
__device__ __forceinline__ void gemm_phase(PG8_LAS unsigned char* lds, const Gemm g, const Sched& S, const Epi& E) {
    const int tid = threadIdx.x, wid = __builtin_amdgcn_readfirstlane(tid >> 6), lane = tid & 63, wr = wid >> 2, wc = wid & 3, fr = lane & 15, fq = lane >> 4;
    const int K = g.K, nt = K / BK;
    unsigned voffA[2], voffB[2];
#pragma unroll
    for (int i = 0; i < 2; ++i) { int R, C; stage_rc(tid * 16 + i * 8192, R, C); const int Rb = Epi::PERM ? ((R & ~31) + perm32(R & 31)) : R;
        voffA[i] = (unsigned)(R * K + C) * 2u; voffB[i] = (unsigned)(Rb * K + C) * 2u; }
    const size_t kstep = (size_t)(BK * 2);
    const size_t hstep = (size_t)HALF * K * 2;
    const size_t tstep = 2 * hstep;
    const unsigned ldsw = (unsigned)wid * 1024u;
    const int aoff = lds_byte(wr * 64 + fr, fq * 8), boff = lds_byte(wc * 32 + fr, fq * 8);
#define PG8_SA(b, h) (((b) * 2 + (h)) * HTB)
#define PG8_SB(b, h) ((4 + (b) * 2 + (h)) * HTB)
#define PG8_STAGE(bufoff, gbase, voff) do { _Pragma("unroll") for (int _i = 0; _i < 2; ++_i) \
        __builtin_amdgcn_global_load_lds((const unsigned*)((const char*)(gbase) + (voff)[_i]), (PG8_LAS unsigned*)(lds + (bufoff) + ldsw + _i * 8192), 16, 0, 0); } while (0)
#define PG8_LDA(dst, b, h) do { _Pragma("unroll") for (int m = 0; m < 4; ++m) _Pragma("unroll") for (int k = 0; k < 2; ++k) dst[m][k] = *(const PG8_LAS bf16x8*)(lds + PG8_SA(b, h) + aoff + m * 2048 + k * 1024); } while (0)
#define PG8_LDB(dst, b, h) do { _Pragma("unroll") for (int n = 0; n < 2; ++n) _Pragma("unroll") for (int k = 0; k < 2; ++k) dst[n][k] = *(const PG8_LAS bf16x8*)(lds + PG8_SB(b, h) + boff + n * 2048 + k * 1024); } while (0)
#define PG8_MMA(ai, bj, At, Bt) do { __builtin_amdgcn_s_setprio(1); _Pragma("unroll") for (int m = 0; m < 4; ++m) _Pragma("unroll") for (int n = 0; n < 2; ++n) _Pragma("unroll") for (int k = 0; k < 2; ++k) \
        acc[ai][bj][m][n] = __builtin_amdgcn_mfma_f32_16x16x32_bf16(Bt[n][k], At[m][k], acc[ai][bj][m][n], 0, 0, 0); __builtin_amdgcn_s_setprio(0); } while (0)
#define PG8_WAIT_V(n) asm volatile("s_waitcnt vmcnt(" #n ")" ::: "memory")
#define PG8_WAIT_L(n) asm volatile("s_waitcnt lgkmcnt(" #n ")" ::: "memory")
#define PG8_BAR __builtin_amdgcn_s_barrier()
#define PG8_SCHED __builtin_amdgcn_sched_barrier(0)
    Unit cur, nxt; int ui = 0;
    if (!S.next(0, cur)) return;
    f32x4 acc[2][2][4][2];
#pragma unroll
    for (int a = 0; a < 2; ++a)
#pragma unroll
        for (int b = 0; b < 2; ++b)
#pragma unroll
            for (int m = 0; m < 4; ++m)
#pragma unroll
                for (int n = 0; n < 2; ++n) acc[a][b][m][n] = (f32x4){0.f, 0.f, 0.f, 0.f};
    bf16x8 At[4][2], B0[2][2], B1[2][2];
    const char* cA = (const char*)g.A + (size_t)cur.pm * tstep; const char* cB = (const char*)g.Bt + (size_t)cur.pn * tstep;
    S.a_ready(cur);
    PG8_STAGE(PG8_SB(0, 0), cB, voffB); PG8_STAGE(PG8_SA(0, 0), cA, voffA); PG8_STAGE(PG8_SB(0, 1), cB + hstep, voffB); PG8_STAGE(PG8_SA(0, 1), cA + hstep, voffA);
    if (wr == 1) PG8_BAR;
    PG8_WAIT_V(4); PG8_BAR;
    PG8_STAGE(PG8_SB(1, 0), cB + kstep, voffB); PG8_STAGE(PG8_SA(1, 0), cA + kstep, voffA); PG8_STAGE(PG8_SB(1, 1), cB + hstep + kstep, voffB);
    PG8_WAIT_V(6); PG8_BAR;
    for (;;) {
        const bool has_next = S.next(ui + 1, nxt);
        const char* nA = has_next ? (const char*)g.A + (size_t)nxt.pm * tstep : cA; const char* nB = has_next ? (const char*)g.Bt + (size_t)nxt.pn * tstep : cB;
        for (int t = 0; t < nt; t += 2) {
            const bool last = (t == nt - 2);
            const char* a1 = cA + (size_t)(t + 1) * kstep;
            const char* a2 = last ? nA : cA + (size_t)(t + 2) * kstep; const char* b2 = last ? nB : cB + (size_t)(t + 2) * kstep;
            const char* a3 = a2 + kstep; const char* b3 = b2 + kstep;
            if (last && has_next) S.a_ready(nxt);
            PG8_LDB(B0, 0, 0); PG8_SCHED; PG8_LDA(At, 0, 0); PG8_STAGE(PG8_SA(1, 1), a1 + hstep, voffA);
            PG8_WAIT_L(8); PG8_BAR; PG8_WAIT_L(0); PG8_MMA(0, 0, At, B0); PG8_BAR; PG8_SCHED;
            PG8_LDB(B1, 0, 1); PG8_STAGE(PG8_SB(0, 0), b2, voffB);
            PG8_BAR; PG8_WAIT_L(0); PG8_MMA(0, 1, At, B1); PG8_BAR;
            PG8_LDA(At, 0, 1); PG8_STAGE(PG8_SA(0, 0), a2, voffA);
            PG8_BAR; PG8_WAIT_L(0); PG8_MMA(1, 0, At, B0); PG8_BAR; PG8_SCHED;
            PG8_STAGE(PG8_SB(0, 1), b2 + hstep, voffB);
            PG8_WAIT_V(6); PG8_BAR; PG8_MMA(1, 1, At, B1); PG8_BAR;
            PG8_LDB(B0, 1, 0); PG8_SCHED; PG8_LDA(At, 1, 0); PG8_STAGE(PG8_SA(0, 1), a2 + hstep, voffA);
            PG8_WAIT_L(8); PG8_BAR; PG8_WAIT_L(0); PG8_MMA(0, 0, At, B0); PG8_BAR; PG8_SCHED;
            PG8_LDB(B1, 1, 1); PG8_STAGE(PG8_SB(1, 0), b3, voffB);
            PG8_BAR; PG8_WAIT_L(0); PG8_MMA(0, 1, At, B1); PG8_BAR;
            PG8_LDA(At, 1, 1); PG8_STAGE(PG8_SA(1, 0), a3, voffA);
            PG8_BAR; PG8_WAIT_L(0); PG8_MMA(1, 0, At, B0); PG8_BAR; PG8_SCHED;
            PG8_STAGE(PG8_SB(1, 1), b3 + hstep, voffB);
            PG8_WAIT_V(6); PG8_BAR; PG8_MMA(1, 1, At, B1); PG8_BAR;
        }
        if constexpr (!Epi::AFTER_DRAIN) { E(acc, cur, wr, wc, fr, fq); S.done(cur); }
        if (!has_next) break;
#pragma unroll
        for (int a = 0; a < 2; ++a)
#pragma unroll
            for (int b = 0; b < 2; ++b)
#pragma unroll
                for (int m = 0; m < 4; ++m)
#pragma unroll
                    for (int n = 0; n < 2; ++n) acc[a][b][m][n] = (f32x4){0.f, 0.f, 0.f, 0.f};
        cur = nxt; cA = nA; cB = nB; ++ui;
    }
    PG8_WAIT_V(0);
    if (wr == 0) PG8_BAR;
    PG8_BAR;
    if constexpr (Epi::AFTER_DRAIN) { E.fused(acc, cur, wr, wc, fr, fq, lds, wid, lane); S.done(cur); }
#undef PG8_SA
#undef PG8_SB
#undef PG8_STAGE
#undef PG8_LDA
#undef PG8_LDB
#undef PG8_MMA
#undef PG8_WAIT_V
#undef PG8_WAIT_L
#undef PG8_BAR
#undef PG8_SCHED
}
}

using pg8::bf16_t; using pg8::bf16x8; using pg8::f32x4; using pg8::u32x4;
#define LAS __attribute__((address_space(3)))
typedef short s16x4 __attribute__((ext_vector_type(4)));
typedef unsigned u32x2 __attribute__((ext_vector_type(2)));

constexpr int D = 2048, NB = 2, SEQ = 4096, NTOK = NB * SEQ, LC = 256, NCTX = NB * LC, MROWS = NTOK + NCTX;
constexpr int DIN = 11296, LDP = 11520, DFF = 5632, NGU = 2 * DFF;
constexpr int C_RK = 0, C_RV = 1024, C_GK = 2048, C_GV = 2560, C_GA = 3584, C_RQ = 3840, C_RG = 4864, C_GQ = 5888, C_GG = 6400, C_GTA = 7424, C_GTB = 9472;
constexpr float EPS = 1e-6f;
constexpr int NTHREADS = 512, LDS_BYTES = 147456;

constexpr size_t WS_W1T = 0;
constexpr size_t WS_HALL = WS_W1T + (size_t)LDP * D * 2;
constexpr size_t WS_OF = WS_W1T, WS_OB = WS_OF + (size_t)NTOK * D * 2, WS_MERGED = WS_W1T;
constexpr size_t WS_WUR = WS_HALL + (size_t)MROWS * D * 2;
constexpr size_t WS_WUG = WS_WUR + (size_t)D * 1024 * 2;
constexpr size_t WS_WOUT = WS_WUG + (size_t)D * 1024 * 2;
constexpr size_t WS_WGU = WS_WOUT + (size_t)D * D * 2;
constexpr size_t WS_WD = WS_WGU + (size_t)NGU * D * 2;
constexpr size_t WS_PALL = WS_WD + (size_t)D * DFF * 2;
constexpr size_t WS_Y = WS_PALL, WS_H2 = WS_Y + (size_t)NTOK * D * 4, WS_ACT = WS_H2 + (size_t)NTOK * D * 2;
constexpr size_t WS_GA = WS_PALL + (size_t)MROWS * LDP * 2;
constexpr size_t WS_MOD = WS_GA + (size_t)MROWS * 32 * 4;
constexpr size_t WS_ROPE = WS_MOD + (size_t)3 * 12288 * 4;
constexpr size_t WS_GKF = WS_ROPE + 2 * 64 * 64 * 4;
constexpr size_t WS_GKB = WS_GKF + (size_t)MROWS * 512 * 2;
constexpr size_t WS_GQF = WS_GKB + (size_t)MROWS * 512 * 2;
constexpr size_t WS_GQB = WS_GQF + (size_t)NTOK * 512 * 2;
constexpr size_t WS_GEL = WS_GQB + (size_t)NTOK * 512 * 2;
constexpr size_t WS_END = WS_GEL + (size_t)136 * 2 * 512 * 4;
static_assert(WS_OB + (size_t)NTOK * D * 2 <= WS_WUR, "o_f/o_b must fit in the dead W1T+HALL region");
static_assert(WS_ACT + (size_t)NTOK * DFF * 2 <= WS_GA, "y/h2/act must fit in the dead PALL region");

struct Params {
    const float *x, *c, *ctx, *c_ctx, *w_mod, *b_mod, *n_mix_pre, *n_mix_post, *n_ffn_pre, *n_ffn_post, *w_in, *ret_decay, *gla_a_up, *gla_a_bias,
        *ret_gn, *gla_gn, *w_up_ret, *w_up_gla, *w_out, *ffn_g, *ffn_u, *ffn_d;
    float* out; unsigned char* ws; int ph_lo, ph_hi;
};

__device__ __forceinline__ float bf_lo(unsigned u) { return __uint_as_float(u << 16); }
__device__ __forceinline__ float bf_hi(unsigned u) { return __uint_as_float(u & 0xffff0000u); }
typedef __bf16 bf16v2_t __attribute__((ext_vector_type(2)));
typedef float f32v2_t __attribute__((ext_vector_type(2)));
__device__ __forceinline__ unsigned pk2(float lo, float hi) { const f32v2_t f = {lo, hi}; const bf16v2_t b = __builtin_convertvector(f, bf16v2_t); return __builtin_bit_cast(unsigned, b); }
__device__ __forceinline__ float wave_sum(float v) {
#pragma unroll
    for (int o = 1; o < 64; o <<= 1) v += __shfl_xor(v, o);
    return v;
}
__device__ __forceinline__ float sigmoidf_(float v) { return 1.0f / (1.0f + __expf(-v)); }
__device__ __forceinline__ float siluf_(float v) { return v / (1.0f + __expf(-v)); }
#define LDS_WAIT() asm volatile("s_waitcnt lgkmcnt(0)" ::: "memory")

__device__ __forceinline__ void tr_item(const float* __restrict__ W, int K, int N, bf16_t* __restrict__ WT, int drow, LAS float* scr, int k0, int n0, int lane) {
#pragma unroll 8
    for (int i = 0; i < 32; ++i) { const int kk = 2 * i + (lane >> 5); scr[kk * 33 + (lane & 31)] = W[(size_t)(k0 + kk) * N + n0 + (lane & 31)]; }
    LDS_WAIT(); __builtin_amdgcn_wave_barrier();
    const int c = lane & 7;
#pragma unroll
    for (int j = 0; j < 4; ++j) { const int n = (lane >> 3) + 8 * j; const LAS float* s = scr + (8 * c) * 33 + n;
        u32x4 o; o.x = pk2(s[0 * 33], s[1 * 33]); o.y = pk2(s[2 * 33], s[3 * 33]); o.z = pk2(s[4 * 33], s[5 * 33]); o.w = pk2(s[6 * 33], s[7 * 33]);
        *(u32x4*)(WT + (size_t)(drow + n) * K + k0 + 8 * c) = o; }
    LDS_WAIT(); __builtin_amdgcn_wave_barrier();
}

__device__ __forceinline__ void phase0(const Params& P, LAS unsigned char* lds) {
    const int tid = threadIdx.x, lane = tid & 63, wave = tid >> 6, G = gridDim.x;
    unsigned char* ws = P.ws;
    for (int item = blockIdx.x; item < 96; item += G) {
        LAS float* sv = (LAS float*)lds;
        LAS float* red = (LAS float*)(lds + 24576);
        for (int i = tid; i < 3 * 2048; i += NTHREADS) { const int r = i >> 11, k = i & 2047; const float v = r < 2 ? P.c[r * 2048 + k] : P.c_ctx[k]; sv[i] = siluf_(v); }
        __syncthreads();
        const int cq = tid & 31, kg = tid >> 5, n0 = item * 128 + cq * 4;
        f32x4 a0 = {0.f, 0.f, 0.f, 0.f}, a1 = a0, a2 = a0;
#pragma unroll 4
        for (int k = kg; k < 2048; k += 16) { const f32x4 w = *(const f32x4*)(P.w_mod + (size_t)k * 12288 + n0); a0 += sv[k] * w; a1 += sv[2048 + k] * w; a2 += sv[4096 + k] * w; }
#pragma unroll
        for (int j = 0; j < 4; ++j) { red[(kg * 3 + 0) * 128 + cq * 4 + j] = a0[j]; red[(kg * 3 + 1) * 128 + cq * 4 + j] = a1[j]; red[(kg * 3 + 2) * 128 + cq * 4 + j] = a2[j]; }
        __syncthreads();
        if (tid < 384) { const int r = tid >> 7, n = tid & 127; float s = 0.f;
#pragma unroll
            for (int g = 0; g < 16; ++g) s += red[(g * 3 + r) * 128 + n];
            ((float*)(ws + WS_MOD))[r * 12288 + item * 128 + n] = s + P.b_mod[item * 128 + n]; }
        __syncthreads();
    }
    if (blockIdx.x == G - 1) {
        float* rope = (float*)(ws + WS_ROPE);
        for (int e = tid; e < 4096; e += NTHREADS) { const int pos = e >> 6, i = e & 63;
            const float inv = powf(10000.0f, -(float)i / 64.0f); const float ang = (float)pos * inv;
            double rev = (double)ang * 0.15915494309189535; rev -= floor(rev); const float fr = (float)rev;
            rope[e] = __builtin_amdgcn_cosf(fr); rope[4096 + e] = __builtin_amdgcn_sinf(fr); }
    }
    { u32x4* z = (u32x4*)(ws + WS_W1T + (size_t)3616 * D * 2); const u32x4 zero = {0u, 0u, 0u, 0u};
      for (int i = blockIdx.x * NTHREADS + tid; i < 224 * D * 2 / 16; i += G * NTHREADS) z[i] = zero; }
    LAS float* scr = (LAS float*)(lds + wave * 8448);
    constexpr int I1 = 32 * (DIN / 32), IU = 16 * 64, IO = 32 * 64, IG = 32 * (DFF / 32), IDN = (DFF / 64) * 64;
    constexpr int NIT = I1 + 2 * IU + IO + 2 * IG + IDN;
    for (int it = blockIdx.x * 8 + wave; it < NIT; it += G * 8) {
        int r = it;
        if (r < I1) { const int nbk = DIN / 32, kb = r / nbk, nb = r % nbk, n0 = nb * 32; tr_item(P.w_in, D, DIN, (bf16_t*)(ws + WS_W1T), n0 < 3616 ? n0 : n0 + 224, scr, kb * 64, n0, lane); continue; } r -= I1;
        if (r < IU) { const int kb = r / 64, nb = r % 64; tr_item(P.w_up_ret, 1024, D, (bf16_t*)(ws + WS_WUR), nb * 32, scr, kb * 64, nb * 32, lane); continue; } r -= IU;
        if (r < IU) { const int kb = r / 64, nb = r % 64; tr_item(P.w_up_gla, 1024, D, (bf16_t*)(ws + WS_WUG), nb * 32, scr, kb * 64, nb * 32, lane); continue; } r -= IU;
        if (r < IO) { const int kb = r / 64, nb = r % 64; tr_item(P.w_out, D, D, (bf16_t*)(ws + WS_WOUT), nb * 32, scr, kb * 64, nb * 32, lane); continue; } r -= IO;
        if (r < IG) { const int nbk = DFF / 32, kb = r / nbk, nb = r % nbk, n0 = nb * 32; tr_item(P.ffn_g, D, DFF, (bf16_t*)(ws + WS_WGU), (n0 >> 7) * 256 + (n0 & 127), scr, kb * 64, n0, lane); continue; } r -= IG;
        if (r < IG) { const int nbk = DFF / 32, kb = r / nbk, nb = r % nbk, n0 = nb * 32; tr_item(P.ffn_u, D, DFF, (bf16_t*)(ws + WS_WGU), (n0 >> 7) * 256 + 128 + (n0 & 127), scr, kb * 64, n0, lane); continue; } r -= IG;
        { const int kb = r / 64, nb = r % 64; tr_item(P.ffn_d, DFF, D, (bf16_t*)(ws + WS_WD), nb * 32, scr, kb * 64, nb * 32, lane); }
    }
}

__device__ __forceinline__ void phase1(const Params& P) {
    const int tid = threadIdx.x, lane = tid & 63, wave = tid >> 6, G = gridDim.x;
    const float* mod = (const float*)(P.ws + WS_MOD);
    bf16_t* hall = (bf16_t*)(P.ws + WS_HALL);
    for (int row = blockIdx.x * 8 + wave; row < MROWS; row += G * 8) {
        const float* src = row < NTOK ? P.x + (size_t)row * D : P.ctx + (size_t)(row - NTOK) * D;
        const int mr = row < NTOK ? row / SEQ : 2;
        const float* sh = mod + (size_t)mr * 12288; const float* sc = sh + 2048;
        f32x4 v[8]; float ss = 0.f;
#pragma unroll
        for (int j = 0; j < 8; ++j) { v[j] = ((const f32x4*)src)[64 * j + lane]; ss += (v[j].x * v[j].x + v[j].y * v[j].y) + (v[j].z * v[j].z + v[j].w * v[j].w); }
        const float rinv = 1.0f / sqrtf(wave_sum(ss) * (1.0f / D) + EPS);
#pragma unroll
        for (int j = 0; j < 8; ++j) { const int c4 = 64 * j + lane; const f32x4 w = ((const f32x4*)P.n_mix_pre)[c4], s = ((const f32x4*)sc)[c4], h = ((const f32x4*)sh)[c4];
            const f32x4 o = v[j] * rinv * w * (s + 1.0f) + h;
            u32x2 pk; pk.x = pk2(o.x, o.y); pk.y = pk2(o.z, o.w); ((u32x2*)(hall + (size_t)row * D))[c4] = pk; }
    }
}

struct EpiP {
    static constexpr bool PERM = true, AFTER_DRAIN = false;
    bf16_t* O; float* ga;
    __device__ __forceinline__ void operator()(const f32x4 (&acc)[2][2][4][2], const pg8::Unit& u, int wr, int wc, int fr, int fq) const {
        const int row0 = u.pm * 256 + wr * 64 + fr, col0 = u.pn * 256 + wc * 32 + 8 * fq;
#pragma unroll
        for (int ai = 0; ai < 2; ++ai)
#pragma unroll
            for (int m = 0; m < 4; ++m) { bf16_t* rowp = O + (size_t)(row0 + ai * 128 + m * 16) * LDP + col0;
#pragma unroll
                for (int bj = 0; bj < 2; ++bj) { const f32x4 v0 = acc[ai][bj][m][0], v1 = acc[ai][bj][m][1];
                    u32x4 w; w.x = pk2(v0[0], v0[1]); w.y = pk2(v0[2], v0[3]); w.z = pk2(v1[0], v1[1]); w.w = pk2(v1[2], v1[3]);
                    *(u32x4*)(rowp + bj * 128) = w; } }
        if (u.pn == 14 && wc == 0) {
#pragma unroll
            for (int ai = 0; ai < 2; ++ai)
#pragma unroll
                for (int m = 0; m < 4; ++m) { float* g = ga + (size_t)(row0 + ai * 128 + m * 16) * 32 + 8 * fq;
                    *(f32x4*)g = acc[ai][0][m][0]; *(f32x4*)(g + 4) = acc[ai][0][m][1]; }
        }
    }
};
template <int SECOND> struct EpiGate {
    static constexpr bool PERM = true, AFTER_DRAIN = false;
    bf16_t* O; const bf16_t* pall;
    __device__ __forceinline__ void operator()(const f32x4 (&acc)[2][2][4][2], const pg8::Unit& u, int wr, int wc, int fr, int fq) const {
        const int row0 = u.pm * 256 + wr * 64 + fr, col0 = u.pn * 256 + wc * 32 + 8 * fq;
#pragma unroll
        for (int ai = 0; ai < 2; ++ai)
#pragma unroll
            for (int m = 0; m < 4; ++m) { const int row = row0 + ai * 128 + m * 16; bf16_t* rowp = O + (size_t)row * D + col0;
                const bf16_t* gp = pall + (size_t)row * LDP + (SECOND ? C_GTB : C_GTA) + col0;
#pragma unroll
                for (int bj = 0; bj < 2; ++bj) { const f32x4 v0 = acc[ai][bj][m][0], v1 = acc[ai][bj][m][1];
                    const u32x4 g = *(const u32x4*)(gp + bj * 128);
                    float r[8];
                    r[0] = sigmoidf_(bf_lo(g.x)) * v0[0]; r[1] = sigmoidf_(bf_hi(g.x)) * v0[1]; r[2] = sigmoidf_(bf_lo(g.y)) * v0[2]; r[3] = sigmoidf_(bf_hi(g.y)) * v0[3];
                    r[4] = sigmoidf_(bf_lo(g.z)) * v1[0]; r[5] = sigmoidf_(bf_hi(g.z)) * v1[1]; r[6] = sigmoidf_(bf_lo(g.w)) * v1[2]; r[7] = sigmoidf_(bf_hi(g.w)) * v1[3];
                    if (SECOND) { const u32x4 p = *(const u32x4*)(rowp + bj * 128);
                        r[0] += bf_lo(p.x); r[1] += bf_hi(p.x); r[2] += bf_lo(p.y); r[3] += bf_hi(p.y); r[4] += bf_lo(p.z); r[5] += bf_hi(p.z); r[6] += bf_lo(p.w); r[7] += bf_hi(p.w); }
                    u32x4 w; w.x = pk2(r[0], r[1]); w.y = pk2(r[2], r[3]); w.z = pk2(r[4], r[5]); w.w = pk2(r[6], r[7]);
                    *(u32x4*)(rowp + bj * 128) = w; } }
    }
};
struct EpiF32 {
    static constexpr bool PERM = false, AFTER_DRAIN = false;
    float* C; int ldc;
    __device__ __forceinline__ void operator()(const f32x4 (&acc)[2][2][4][2], const pg8::Unit& u, int wr, int wc, int fr, int fq) const {
        const int row0 = u.pm * 256 + wr * 64 + fr, col0 = u.pn * 256 + wc * 32 + 4 * fq;
#pragma unroll
        for (int ai = 0; ai < 2; ++ai)
#pragma unroll
            for (int m = 0; m < 4; ++m) { float* rowp = C + (size_t)(row0 + ai * 128 + m * 16) * ldc + col0;
#pragma unroll
                for (int bj = 0; bj < 2; ++bj)
#pragma unroll
                    for (int n = 0; n < 2; ++n) *(f32x4*)(rowp + bj * 128 + n * 16) = acc[ai][bj][m][n]; }
    }
};
struct EpiSwiGLU {
    static constexpr bool PERM = true, AFTER_DRAIN = false;
    bf16_t* O;
    __device__ __forceinline__ void operator()(const f32x4 (&acc)[2][2][4][2], const pg8::Unit& u, int wr, int wc, int fr, int fq) const {
        const int row0 = u.pm * 256 + wr * 64 + fr, col0 = u.pn * 128 + wc * 32 + 8 * fq;
#pragma unroll
        for (int ai = 0; ai < 2; ++ai)
#pragma unroll
            for (int m = 0; m < 4; ++m) { bf16_t* rowp = O + (size_t)(row0 + ai * 128 + m * 16) * DFF + col0;
                const f32x4 g0 = acc[ai][0][m][0], g1 = acc[ai][0][m][1], u0 = acc[ai][1][m][0], u1 = acc[ai][1][m][1];
                u32x4 w; w.x = pk2(siluf_(g0[0]) * u0[0], siluf_(g0[1]) * u0[1]); w.y = pk2(siluf_(g0[2]) * u0[2], siluf_(g0[3]) * u0[3]);
                w.z = pk2(siluf_(g1[0]) * u1[0], siluf_(g1[1]) * u1[1]); w.w = pk2(siluf_(g1[2]) * u1[2], siluf_(g1[3]) * u1[3]);
                *(u32x4*)rowp = w; }
    }
};

__device__ __forceinline__ void phase25(const Params& P, LAS unsigned char* lds) {
    const int tid = threadIdx.x, lane = tid & 63, wave = tid >> 6, G = gridDim.x;
    bf16_t* pall = (bf16_t*)(P.ws + WS_PALL);
    {
        LAS float* GAc = (LAS float*)lds;
        LAS float* TOT = (LAS float*)(lds + 8192);
        const int dp = tid & 63, tg = tid >> 6;
        const float* gaw = (const float*)(P.ws + WS_GA);
        for (int item = blockIdx.x; item < 136 * 4; item += G) {
            const int cb = item >> 2, h = item & 3, rowbase = cb * 64; const bool isctx = cb >= 128;
            if (tid < 512) { const int t = tid >> 3, part = tid & 7; *(LAS f32x4*)(GAc + t * 32 + part * 4) = *(const f32x4*)(gaw + (size_t)(rowbase + t) * 32 + part * 4); }
            unsigned kv[8], qv[8];
#pragma unroll
            for (int j = 0; j < 8; ++j) { const bf16_t* rp = pall + (size_t)(rowbase + tg * 8 + j) * LDP; kv[j] = *(const unsigned*)(rp + C_GK + h * 128 + 2 * dp); qv[j] = isctx ? 0u : *(const unsigned*)(rp + C_GQ + h * 128 + 2 * dp); }
            __syncthreads();
#pragma unroll 1
            for (int dir = 0; dir < 2; ++dir) {
                float aup0[16], aup1[16];
#pragma unroll
                for (int r = 0; r < 16; ++r) { aup0[r] = P.gla_a_up[(size_t)(dir * 16 + r) * 512 + h * 128 + 2 * dp]; aup1[r] = P.gla_a_up[(size_t)(dir * 16 + r) * 512 + h * 128 + 2 * dp + 1]; }
                const float bias0 = P.gla_a_bias[dir * 512 + h * 128 + 2 * dp], bias1 = P.gla_a_bias[dir * 512 + h * 128 + 2 * dp + 1];
                float b0[8], b1[8];
#pragma unroll
                for (int j = 0; j < 8; ++j) { const LAS float* g = GAc + (tg * 8 + j) * 32 + dir * 16; float z0 = bias0, z1 = bias1;
#pragma unroll
                    for (int r = 0; r < 16; ++r) { const float gv = g[r]; z0 += gv * aup0[r]; z1 += gv * aup1[r]; }
                    b0[j] = (fminf(z0, 0.f) - __logf(1.0f + __expf(-fabsf(z0)))) * 0.0625f; b1[j] = (fminf(z1, 0.f) - __logf(1.0f + __expf(-fabsf(z1)))) * 0.0625f; }
                float r0 = 0.f, r1 = 0.f;
                if (dir == 0) {
#pragma unroll
                    for (int j = 0; j < 8; ++j) { r0 += b0[j]; b0[j] = r0; r1 += b1[j]; b1[j] = r1; }
                } else {
#pragma unroll
                    for (int j = 7; j >= 0; --j) { r0 += b0[j]; b0[j] = r0; r1 += b1[j]; b1[j] = r1; }
                }
                TOT[tg * 128 + 2 * dp] = r0; TOT[tg * 128 + 2 * dp + 1] = r1;
                __syncthreads();
                float off0 = 0.f, off1 = 0.f, tot0 = 0.f, tot1 = 0.f;
#pragma unroll
                for (int g = 0; g < 8; ++g) { const float a0 = TOT[g * 128 + 2 * dp], a1 = TOT[g * 128 + 2 * dp + 1]; tot0 += a0; tot1 += a1;
                    const bool inc = dir == 0 ? (g < tg) : (g > tg); off0 += inc ? a0 : 0.f; off1 += inc ? a1 : 0.f; }
                bf16_t* gk = (bf16_t*)(P.ws + (dir ? WS_GKB : WS_GKF)); bf16_t* gq = (bf16_t*)(P.ws + (dir ? WS_GQB : WS_GQF));
#pragma unroll
                for (int j = 0; j < 8; ++j) { const int row = rowbase + tg * 8 + j; const float e0 = b0[j] + off0, e1 = b1[j] + off1;
                    *(unsigned*)(gk + (size_t)row * 512 + h * 128 + 2 * dp) = pk2(bf_lo(kv[j]) * __expf(-e0), bf_hi(kv[j]) * __expf(-e1));
                    if (!isctx) *(unsigned*)(gq + (size_t)row * 512 + h * 128 + 2 * dp) = pk2(bf_lo(qv[j]) * (0.08838834764831845f * __expf(e0)), bf_hi(qv[j]) * (0.08838834764831845f * __expf(e1))); }
                if (tg == 0) { float* el = (float*)(P.ws + WS_GEL) + (size_t)(cb * 2 + dir) * 512 + h * 128; el[2 * dp] = __expf(tot0); el[2 * dp + 1] = __expf(tot1); }
                __syncthreads();
            }
        }
    }
    {
        const float* rope = (const float*)(P.ws + WS_ROPE);
        for (int row = blockIdx.x * 8 + wave; row < NTOK; row += G * 8) {
            const int t = row & (SEQ - 1), pos = lane < 32 ? (t >> 6) : (t & 63), i0 = (2 * lane) & 63;
            const float c0 = rope[pos * 64 + i0], c1 = rope[pos * 64 + i0 + 1], s0 = rope[4096 + pos * 64 + i0], s1 = rope[4096 + pos * 64 + i0 + 1];
            bf16_t* rp = pall + (size_t)row * LDP;
#pragma unroll
            for (int it = 0; it < 8; ++it) { const int col = (it < 4 ? C_RK : C_RQ) + (it & 3) * 256 + 2 * lane; const float sc = it < 4 ? 1.0f : 0.0625f;
                const unsigned a = *(const unsigned*)(rp + col), bb = *(const unsigned*)(rp + col + 128);
                const float t1a = bf_lo(a), t1b = bf_hi(a), t2a = bf_lo(bb), t2b = bf_hi(bb);
                *(unsigned*)(rp + col) = pk2((t1a * c0 - t2a * s0) * sc, (t1b * c1 - t2b * s1) * sc);
                *(unsigned*)(rp + col + 128) = pk2((t1a * s0 + t2a * c0) * sc, (t1b * s1 + t2b * c1) * sc); }
        }
    }
}

__device__ __forceinline__ bf16x8 tr_frag(LAS unsigned char* X, int pitchB, int k0, int c0, int lane) {
    const int i = lane & 15, Q = lane >> 4;
    const int off = (k0 + Q * 8 + (i >> 2)) * pitchB + (c0 + 4 * (i & 3)) * 2;
    const s16x4 lo = __builtin_amdgcn_ds_read_tr16_b64_v4i16((LAS s16x4*)(X + off));
    const s16x4 hi = __builtin_amdgcn_ds_read_tr16_b64_v4i16((LAS s16x4*)(X + off + 4 * pitchB));
    bf16x8 r; r[0] = lo[0]; r[1] = lo[1]; r[2] = lo[2]; r[3] = lo[3]; r[4] = hi[0]; r[5] = hi[1]; r[6] = hi[2]; r[7] = hi[3]; return r;
}
#define MFMA16(a, b, c) __builtin_amdgcn_mfma_f32_16x16x32_bf16(a, b, c, 0, 0, 0)

template <int DK, bool RET>
__device__ __forceinline__ void chain_run(const Params& P, int chain, LAS unsigned char* lds) {
    constexpr int PQ = (DK + 8) * 2, PV = 80, PP = 144;
    constexpr int O_QD = 0, O_KD = O_QD + 64 * PQ, O_VV = O_KD + 64 * PQ, O_VS = O_VV + 64 * PV, O_PP = O_VS + 64 * PV, O_ST = O_PP + 64 * PP, O_EL = O_ST + 32 * PQ;
    constexpr int MT = DK / 128;
    constexpr int NPC = DK / 64, RPC = DK / 8;
    const int tid = threadIdx.x, lane = tid & 63, wave = tid >> 6, l15 = lane & 15, quad = lane >> 4;
    const int s = chain & 7, dir = (chain >> 3) & 1, h = (chain >> 4) & 3, b = chain >> 6;
    const bf16_t* pall = (const bf16_t*)(P.ws + WS_PALL);
    const bf16_t* qsrc = RET ? pall + C_RQ + h * 256 : (const bf16_t*)(P.ws + (dir ? WS_GQB : WS_GQF)) + h * 128;
    const bf16_t* ksrc = RET ? pall + C_RK + h * 256 : (const bf16_t*)(P.ws + (dir ? WS_GKB : WS_GKF)) + h * 128;
    constexpr int QLD = RET ? LDP : 512;
    const int vcol = (RET ? C_RV : C_GV) + h * 256 + s * 32;
    bf16_t* obase = (bf16_t*)(P.ws + (dir ? WS_OB : WS_OF)) + (RET ? 0 : 1024) + h * 256 + s * 32;
    LAS unsigned char* QD = lds + O_QD; LAS unsigned char* KD = lds + O_KD; LAS unsigned char* VV = lds + O_VV; LAS unsigned char* VS = lds + (RET ? O_VS : O_VV);
    LAS unsigned char* PPb = lds + O_PP; LAS unsigned char* ST = lds + O_ST; LAS float* EL = (LAS float*)(lds + O_EL);
#pragma nounroll
    for (int i = tid; i < 32 * PQ / 4; i += NTHREADS) ((LAS unsigned*)ST)[i] = 0u;
    const int ti = wave >> 1, tn = wave & 1, tj0 = (wave & 1) * 2;
    float dm0[4], dm1[4], rsc[4], vw = 1.f, elast = 1.f;
    if (RET) {
        const float lg = -__expf(P.ret_decay[dir * 4 + h]);
#pragma unroll
        for (int r = 0; r < 4; ++r) { const int i = ti * 16 + quad * 4 + r, j0 = tj0 * 16 + l15, j1 = j0 + 16;
            dm0[r] = dir ? (j0 > i ? __expf((float)(j0 - i) * lg) : 0.f) : (j0 <= i ? __expf((float)(i - j0) * lg) : 0.f);
            dm1[r] = dir ? (j1 > i ? __expf((float)(j1 - i) * lg) : 0.f) : (j1 <= i ? __expf((float)(i - j1) * lg) : 0.f);
            rsc[r] = __expf((dir ? (float)(64 - i) : (float)(i + 1)) * lg); }
        const int t = tid >> 2; vw = __expf((dir ? (float)t : (float)(63 - t)) * lg); elast = __expf(64.0f * lg);
    } else {
#pragma unroll
        for (int r = 0; r < 4; ++r) { const int i = ti * 16 + quad * 4 + r, j0 = tj0 * 16 + l15, j1 = j0 + 16;
            dm0[r] = (dir ? (j0 > i) : (j0 <= i)) ? 1.f : 0.f; dm1[r] = (dir ? (j1 > i) : (j1 <= i)) ? 1.f : 0.f; rsc[r] = 1.f; }
    }
    f32x4 sacc[MT][2];
#pragma unroll
    for (int a = 0; a < MT; ++a) { sacc[a][0] = (f32x4){0.f, 0.f, 0.f, 0.f}; sacc[a][1] = (f32x4){0.f, 0.f, 0.f, 0.f}; }

#define LBAR() do { asm volatile("s_waitcnt lgkmcnt(0)" ::: "memory"); __builtin_amdgcn_s_barrier(); asm volatile("" ::: "memory"); } while (0)
    auto chunk_of = [&](int step, bool& isctx, int& cidx, int& rowbase) __attribute__((always_inline)) {
        isctx = step < 4;
        cidx = isctx ? (dir ? 3 - step : step) : (dir ? 63 - (step - 4) : step - 4);
        rowbase = isctx ? NTOK + b * LC + cidx * 64 : b * SEQ + cidx * 64; };
    u32x4 rq[NPC], rk[NPC], rv; float rel = 0.f;
    auto issue = [&](int step) __attribute__((always_inline)) {
        bool isctx; int cidx, rowbase; chunk_of(step, isctx, cidx, rowbase);
#pragma unroll
        for (int u = 0; u < NPC; ++u) { const int id = tid + NTHREADS * u, t = id / RPC, c = id % RPC;
            rk[u] = *(const u32x4*)(ksrc + (size_t)(rowbase + t) * QLD + c * 8);
            if (!isctx) rq[u] = *(const u32x4*)(qsrc + (size_t)(rowbase + t) * QLD + c * 8); }
        if (tid < 256) rv = *(const u32x4*)(pall + (size_t)(rowbase + (tid >> 2)) * LDP + vcol + (tid & 3) * 8);
        if (!RET && tid < 128) rel = ((const float*)(P.ws + WS_GEL))[(size_t)((rowbase >> 6) * 2 + dir) * 512 + h * 128 + tid];
    };
    issue(0);
    __syncthreads();
    for (int step = 0; step < 68; ++step) {
        bool isctx; int cidx, rowbase; chunk_of(step, isctx, cidx, rowbase);
#pragma unroll
        for (int u = 0; u < NPC; ++u) { const int id = tid + NTHREADS * u, t = id / RPC, c = id % RPC;
            *(LAS u32x4*)(KD + t * PQ + c * 16) = rk[u]; if (!isctx) *(LAS u32x4*)(QD + t * PQ + c * 16) = rq[u]; }
        if (tid < 256) { *(LAS u32x4*)(VV + (tid >> 2) * PV + (tid & 3) * 16) = rv;
            if (RET) { u32x4 w; w.x = pk2(bf_lo(rv.x) * vw, bf_hi(rv.x) * vw); w.y = pk2(bf_lo(rv.y) * vw, bf_hi(rv.y) * vw); w.z = pk2(bf_lo(rv.z) * vw, bf_hi(rv.z) * vw); w.w = pk2(bf_lo(rv.w) * vw, bf_hi(rv.w) * vw);
                *(LAS u32x4*)(VS + (tid >> 2) * PV + (tid & 3) * 16) = w; } }
        if (!RET && tid < 128) EL[tid] = rel;
        LBAR();
        if (step + 1 < 68) issue(step + 1);
        f32x4 oacc = {0.f, 0.f, 0.f, 0.f};
        if (!isctx) {
            f32x4 p0 = {0.f, 0.f, 0.f, 0.f}, p1 = p0;
#pragma unroll
            for (int k0 = 0; k0 < DK; k0 += 32) {
                const bf16x8 a = *(LAS bf16x8*)(QD + (ti * 16 + l15) * PQ + (k0 + quad * 8) * 2);
                const bf16x8 k0f = *(LAS bf16x8*)(KD + (tj0 * 16 + l15) * PQ + (k0 + quad * 8) * 2);
                const bf16x8 k1f = *(LAS bf16x8*)(KD + ((tj0 + 1) * 16 + l15) * PQ + (k0 + quad * 8) * 2);
                const bf16x8 sf = *(LAS bf16x8*)(ST + (tn * 16 + l15) * PQ + (k0 + quad * 8) * 2);
                p0 = MFMA16(a, k0f, p0); p1 = MFMA16(a, k1f, p1); oacc = MFMA16(a, sf, oacc);
            }
#pragma unroll
            for (int r = 0; r < 4; ++r) { const int i = ti * 16 + quad * 4 + r, j0 = tj0 * 16 + l15, j1 = j0 + 16;
                const unsigned w0 = pk2(p0[r] * dm0[r], 0.f), w1 = pk2(p1[r] * dm1[r], 0.f);
                *(LAS unsigned short*)(PPb + i * PP + j0 * 2) = (unsigned short)w0; *(LAS unsigned short*)(PPb + i * PP + j1 * 2) = (unsigned short)w1;
                if (RET) oacc[r] *= rsc[r]; }
        }
        LBAR();
        if (!isctx) {
            const bf16x8 pa = *(LAS bf16x8*)(PPb + (ti * 16 + l15) * PP + (quad * 8) * 2), pb = *(LAS bf16x8*)(PPb + (ti * 16 + l15) * PP + (32 + quad * 8) * 2);
            const bf16x8 va = tr_frag(VV, PV, 0, tn * 16, lane), vb = tr_frag(VV, PV, 32, tn * 16, lane);
            oacc = MFMA16(pa, va, oacc); oacc = MFMA16(pb, vb, oacc);
#pragma unroll
            for (int r = 0; r < 4; ++r) { const int i = ti * 16 + quad * 4 + r; obase[(size_t)(rowbase + i) * D + tn * 16 + l15] = (bf16_t)(pk2(oacc[r], 0.f) & 0xffffu); }
        }
        const bf16x8 vf0a = tr_frag(VS, PV, 0, 0, lane), vf0b = tr_frag(VS, PV, 32, 0, lane), vf1a = tr_frag(VS, PV, 0, 16, lane), vf1b = tr_frag(VS, PV, 32, 16, lane);
#pragma unroll
        for (int a = 0; a < MT; ++a) { const int mt = wave * MT + a;
            const bf16x8 ka = tr_frag(KD, PQ, 0, mt * 16, lane), kb = tr_frag(KD, PQ, 32, mt * 16, lane);
            if (RET) { sacc[a][0] *= elast; sacc[a][1] *= elast; }
            sacc[a][0] = MFMA16(ka, vf0a, sacc[a][0]); sacc[a][0] = MFMA16(kb, vf0b, sacc[a][0]);
            sacc[a][1] = MFMA16(ka, vf1a, sacc[a][1]); sacc[a][1] = MFMA16(kb, vf1b, sacc[a][1]);
            if (!RET) { const f32x4 el = *(LAS f32x4*)(EL + mt * 16 + quad * 4); sacc[a][0] *= el; sacc[a][1] *= el; }
            u32x2 w0, w1; w0.x = pk2(sacc[a][0][0], sacc[a][0][1]); w0.y = pk2(sacc[a][0][2], sacc[a][0][3]); w1.x = pk2(sacc[a][1][0], sacc[a][1][1]); w1.y = pk2(sacc[a][1][2], sacc[a][1][3]);
            *(LAS u32x2*)(ST + (l15) * PQ + (mt * 16 + quad * 4) * 2) = w0; *(LAS u32x2*)(ST + (16 + l15) * PQ + (mt * 16 + quad * 4) * 2) = w1; }
        LBAR();
    }
    asm volatile("s_waitcnt vmcnt(0)" ::: "memory");
#undef LBAR
}

__device__ __forceinline__ void phase3(const Params& P, LAS unsigned char* lds) {
    for (int blk = blockIdx.x; blk < 256; blk += gridDim.x) {
        const int x = blk & 7, y = blk >> 3, grp = x * 4 + (y >> 3), s = y & 7, idx = grp >> 1;
        const int chain = (idx << 3) | s;
        if (grp & 1) chain_run<128, false>(P, chain, lds); else chain_run<256, true>(P, chain, lds);
        __syncthreads();
    }
}

__device__ __forceinline__ void phase4(const Params& P) {
    const int tid = threadIdx.x, lane = tid & 63, wave = tid >> 6, G = gridDim.x;
    const bf16_t* of = (const bf16_t*)(P.ws + WS_OF); const bf16_t* ob = (const bf16_t*)(P.ws + WS_OB); const bf16_t* pall = (const bf16_t*)(P.ws + WS_PALL);
    bf16_t* onr = (bf16_t*)P.out; bf16_t* ong = onr + (size_t)NTOK * 1024;
    for (int T = blockIdx.x * 8 + wave; T < NTOK; T += G * 8) {
#pragma unroll
        for (int hh = 0; hh < 8; ++hh) {
            const int col = hh * 256 + lane * 4;
            const u32x2 a = *(const u32x2*)(of + (size_t)T * D + col), bb = *(const u32x2*)(ob + (size_t)T * D + col);
            float v[4] = {bf_lo(a.x) + bf_lo(bb.x), bf_hi(a.x) + bf_hi(bb.x), bf_lo(a.y) + bf_lo(bb.y), bf_hi(a.y) + bf_hi(bb.y)};
            const bool ret = hh < 4; const int hc = (hh & 3) * 256 + lane * 4;
            const u32x2 gt = *(const u32x2*)(pall + (size_t)T * LDP + (ret ? C_RG : C_GG) + hc);
            const f32x4 gn = *(const f32x4*)((ret ? P.ret_gn : P.gla_gn) + hc);
            float rs;
            if (ret) { const float mean = wave_sum((v[0] + v[1]) + (v[2] + v[3])) * (1.0f / 256.0f);
#pragma unroll
                for (int e = 0; e < 4; ++e) v[e] -= mean; }
            rs = 1.0f / sqrtf(wave_sum((v[0] * v[0] + v[1] * v[1]) + (v[2] * v[2] + v[3] * v[3])) * (1.0f / 256.0f) + EPS);
            u32x2 o; o.x = pk2(v[0] * rs * gn.x * siluf_(bf_lo(gt.x)), v[1] * rs * gn.y * siluf_(bf_hi(gt.x))); o.y = pk2(v[2] * rs * gn.z * siluf_(bf_lo(gt.y)), v[3] * rs * gn.w * siluf_(bf_hi(gt.y)));
            *(u32x2*)((ret ? onr : ong) + (size_t)T * 1024 + hc) = o;
        }
    }
}

__device__ __forceinline__ void phase7(const Params& P) {
    const int tid = threadIdx.x, lane = tid & 63, wave = tid >> 6, G = gridDim.x;
    const float* mod = (const float*)(P.ws + WS_MOD); const float* Y = (const float*)(P.ws + WS_Y); bf16_t* h2 = (bf16_t*)(P.ws + WS_H2);
    for (int row = blockIdx.x * 8 + wave; row < NTOK; row += G * 8) {
        const float* mb = mod + (size_t)(row / SEQ) * 12288;
        f32x4 v[8]; float ss = 0.f;
#pragma unroll
        for (int j = 0; j < 8; ++j) { v[j] = ((const f32x4*)(Y + (size_t)row * D))[64 * j + lane]; ss += (v[j].x * v[j].x + v[j].y * v[j].y) + (v[j].z * v[j].z + v[j].w * v[j].w); }
        const float rinv = 1.0f / sqrtf(wave_sum(ss) * (1.0f / D) + EPS);
        float ss2 = 0.f;
#pragma unroll
        for (int j = 0; j < 8; ++j) { const int c4 = 64 * j + lane; const f32x4 xv = ((const f32x4*)(P.x + (size_t)row * D))[c4], w = ((const f32x4*)P.n_mix_post)[c4], g1 = ((const f32x4*)(mb + 4096))[c4];
            v[j] = xv + g1 * (v[j] * rinv * w); ((f32x4*)(P.out + (size_t)row * D))[c4] = v[j];
            ss2 += (v[j].x * v[j].x + v[j].y * v[j].y) + (v[j].z * v[j].z + v[j].w * v[j].w); }
        const float rinv2 = 1.0f / sqrtf(wave_sum(ss2) * (1.0f / D) + EPS);
#pragma unroll
        for (int j = 0; j < 8; ++j) { const int c4 = 64 * j + lane; const f32x4 w = ((const f32x4*)P.n_ffn_pre)[c4], sh = ((const f32x4*)(mb + 6144))[c4], sc = ((const f32x4*)(mb + 8192))[c4];
            const f32x4 o = v[j] * rinv2 * w * (sc + 1.0f) + sh;
            u32x2 pk; pk.x = pk2(o.x, o.y); pk.y = pk2(o.z, o.w); ((u32x2*)(h2 + (size_t)row * D))[c4] = pk; }
    }
}
__device__ __forceinline__ void phase10(const Params& P) {
    const int tid = threadIdx.x, lane = tid & 63, wave = tid >> 6, G = gridDim.x;
    const float* mod = (const float*)(P.ws + WS_MOD); const float* Y = (const float*)(P.ws + WS_Y);
    for (int row = blockIdx.x * 8 + wave; row < NTOK; row += G * 8) {
        const float* mb = mod + (size_t)(row / SEQ) * 12288;
        f32x4 v[8]; float ss = 0.f;
#pragma unroll
        for (int j = 0; j < 8; ++j) { v[j] = ((const f32x4*)(Y + (size_t)row * D))[64 * j + lane]; ss += (v[j].x * v[j].x + v[j].y * v[j].y) + (v[j].z * v[j].z + v[j].w * v[j].w); }
        const float rinv = 1.0f / sqrtf(wave_sum(ss) * (1.0f / D) + EPS);
#pragma unroll
        for (int j = 0; j < 8; ++j) { const int c4 = 64 * j + lane; f32x4* op = (f32x4*)(P.out + (size_t)row * D) + c4; const f32x4 hs = *op, w = ((const f32x4*)P.n_ffn_post)[c4], g2 = ((const f32x4*)(mb + 10240))[c4];
            *op = hs + g2 * (v[j] * rinv * w); }
    }
}

__global__ __launch_bounds__(512, 2) void hybrid_block_fwd(Params P) {
    extern __shared__ __attribute__((aligned(16))) unsigned char shm[];
    LAS unsigned char* lds = (LAS unsigned char*)shm;
    cg::grid_group grid = cg::this_grid();
    unsigned char* ws = P.ws;
    const int G = gridDim.x, c = blockIdx.x;
#ifndef REPEAT_PHASE
#define REPEAT_PHASE -1
#endif
#define PHASE(n, ...) if (P.ph_lo <= (n) && (n) < P.ph_hi) { if ((n) == REPEAT_PHASE) { __VA_ARGS__; asm volatile("s_waitcnt vmcnt(0)" ::: "memory"); grid.sync(); } __VA_ARGS__; if ((n) + 1 < P.ph_hi) { asm volatile("s_waitcnt vmcnt(0)" ::: "memory"); grid.sync(); } }
    PHASE(0, phase0(P, lds))
    PHASE(1, phase1(P))
    PHASE(2, { pg8::Gemm g{(const bf16_t*)(ws + WS_HALL), (const bf16_t*)(ws + WS_W1T), MROWS, LDP, D}; pg8::StaticOrder S; S.init(MROWS, LDP, G, c);
               EpiP E{(bf16_t*)(ws + WS_PALL), (float*)(ws + WS_GA)}; pg8::gemm_phase(lds, g, S, E); })
    PHASE(3, phase25(P, lds))
    PHASE(4, phase3(P, lds))
    PHASE(5, phase4(P))
    PHASE(6, { pg8::StaticOrder S; S.init(NTOK, D, G, c);
               { pg8::Gemm g{(const bf16_t*)P.out, (const bf16_t*)(ws + WS_WUR), NTOK, D, 1024}; EpiGate<0> E{(bf16_t*)(ws + WS_MERGED), (const bf16_t*)(ws + WS_PALL)}; pg8::gemm_phase(lds, g, S, E); }
               { pg8::Gemm g{(const bf16_t*)P.out + (size_t)NTOK * 1024, (const bf16_t*)(ws + WS_WUG), NTOK, D, 1024}; EpiGate<1> E{(bf16_t*)(ws + WS_MERGED), (const bf16_t*)(ws + WS_PALL)}; pg8::gemm_phase(lds, g, S, E); } })
    PHASE(7, { pg8::Gemm g{(const bf16_t*)(ws + WS_MERGED), (const bf16_t*)(ws + WS_WOUT), NTOK, D, D}; pg8::StaticOrder S; S.init(NTOK, D, G, c);
               EpiF32 E{(float*)(ws + WS_Y), D}; pg8::gemm_phase(lds, g, S, E); })
    PHASE(8, phase7(P))
    PHASE(9, { pg8::Gemm g{(const bf16_t*)(ws + WS_H2), (const bf16_t*)(ws + WS_WGU), NTOK, NGU, D}; pg8::StaticOrder S; S.init(NTOK, NGU, G, c);
               EpiSwiGLU E{(bf16_t*)(ws + WS_ACT)}; pg8::gemm_phase(lds, g, S, E); })
    PHASE(10, { pg8::Gemm g{(const bf16_t*)(ws + WS_ACT), (const bf16_t*)(ws + WS_WD), NTOK, D, DFF}; pg8::StaticOrder S; S.init(NTOK, D, G, c);
               EpiF32 E{(float*)(ws + WS_Y), D}; pg8::gemm_phase(lds, g, S, E); })
    PHASE(11, phase10(P))
#undef PHASE
}

#ifndef N_LAUNCH_MODE
#define N_LAUNCH_MODE 1
#endif
extern "C" void kernel_launch(void* const* d_in, const int* in_sizes, int n_in, void* d_out, int out_size, void* d_ws, size_t ws_size, hipStream_t stream) {
    static int grid = 0;
    if (grid == 0) {
        if (n_in != 22 || out_size != NTOK * D || ws_size < WS_END) { fprintf(stderr, "kernel_launch: unexpected sizes (n_in %d out %d ws %zu need %zu)\n", n_in, out_size, ws_size, (size_t)WS_END); grid = -1; return; }
        int dev = 0, cus = 0, per_cu = 0;
        hipGetDevice(&dev); hipDeviceGetAttribute(&cus, hipDeviceAttributeMultiprocessorCount, dev);
        if (hipFuncSetAttribute((const void*)hybrid_block_fwd, hipFuncAttributeMaxDynamicSharedMemorySize, LDS_BYTES) != hipSuccess) { fprintf(stderr, "kernel_launch: hipFuncSetAttribute failed\n"); grid = -1; return; }
        if (hipOccupancyMaxActiveBlocksPerMultiprocessor(&per_cu, (const void*)hybrid_block_fwd, NTHREADS, LDS_BYTES) != hipSuccess || per_cu < 1) { fprintf(stderr, "kernel_launch: occupancy query says %d\n", per_cu); (void)hipGetLastError(); per_cu = 1; }
        grid = cus * 1;
        fprintf(stderr, "kernel_launch: grid %d (cus %d, per_cu %d)\n", grid, cus, per_cu);
    }
    if (grid < 0) return;
    Params p; memset(&p, 0, sizeof(p));
    const float** pp = (const float**)&p;
    for (int i = 0; i < 22; ++i) pp[i] = (const float*)d_in[i];
    p.out = (float*)d_out; p.ws = (unsigned char*)d_ws;
#if N_LAUNCH_MODE == 1
    p.ph_lo = 0; p.ph_hi = 12;
    { void* args[] = {&p}; hipError_t e = hipLaunchCooperativeKernel((void*)hybrid_block_fwd, dim3(grid), dim3(NTHREADS), args, LDS_BYTES, stream);
      if (e != hipSuccess) fprintf(stderr, "cooperative launch failed: %s (grid %d)\n", hipGetErrorString(e), grid); }
#else
    for (int ph = 0; ph < 12; ++ph) { p.ph_lo = ph; p.ph_hi = ph + 1; void* args[] = {&p};
        hipError_t e = hipLaunchCooperativeKernel((void*)hybrid_block_fwd, dim3(grid), dim3(NTHREADS), args, LDS_BYTES, stream);
        if (e != hipSuccess) fprintf(stderr, "cooperative launch %d failed: %s (grid %d)\n", ph, hipGetErrorString(e), grid); }
#endif
}
```
